# Optimizing an MI355X kernel written in HIP

```python
import math
import jax, jax.numpy as jnp
from jax import lax
import numpy as np

D_MODEL = 1024
BATCH = 16
SEQ = 4096
DEPTH = 2
DEC_BATCH = 1
DEC_SEQ = 16384
PAST_LEN = 128

MIX_WIDTH = D_MODEL
FOURIER_WIDTH = D_MODEL // 2
N_FOURIER_GROUPS = 4
FOURIER_GROUP = FOURIER_WIDTH // N_FOURIER_GROUPS
HEAD_DIM = 64
N_HEADS = (MIX_WIDTH - FOURIER_WIDTH) // HEAD_DIM
N_KV_HEADS = 2
Q_PER_KV = N_HEADS // N_KV_HEADS
ATTN_WIDTH = N_HEADS * HEAD_DIM
KV_WIDTH = N_KV_HEADS * HEAD_DIM
IN_WIDTH = FOURIER_WIDTH + ATTN_WIDTH + 2 * KV_WIDTH
WINDOW = 128
BLOCK = 128
D_FF = 4 * D_MODEL
LN_EPS = 1e-5
DEEPNORM_ALPHA = (2.0 * DEPTH) ** 0.25
DEEPNORM_BETA = (8.0 * DEPTH) ** -0.25
NEG_BIG = -1e30

kernel_name = 'hymba_fnet_swa_alibi_deepnorm_encoder'


def layer_norm(x, g, b):
    xf = x.astype(jnp.float32)
    mu = jnp.mean(xf, axis=-1, keepdims=True)
    var = jnp.mean(jnp.square(xf - mu), axis=-1, keepdims=True)
    y = (xf - mu) * lax.rsqrt(var + LN_EPS) * g.astype(jnp.float32) + b.astype(jnp.float32)
    return y.astype(x.dtype)


def alibi_slopes():
    h = jnp.arange(N_HEADS, dtype=jnp.float32)
    return jnp.exp2(-8.0 * (h + 1.0) / N_HEADS)


def fourier_mix(u, w_fourier):
    B, S, _ = u.shape
    ug = u.reshape(B, S, N_FOURIER_GROUPS, FOURIER_GROUP).astype(jnp.float32)
    f = jnp.real(jnp.fft.fft2(ug, axes=(1, 3), norm='ortho')).astype(u.dtype)
    out = jnp.einsum('bsgc,gcd->bsgd', f, w_fourier)
    return out.reshape(B, S, FOURIER_WIDTH)


def windowed_attention(q, k, v, sink_logits):
    B, S, _ = q.shape
    nb = S // BLOCK
    qb = q.reshape(B, nb, BLOCK, N_KV_HEADS, Q_PER_KV, HEAD_DIM)

    def band(t):
        t = t.reshape(B, S, N_KV_HEADS, HEAD_DIM)
        tp = jnp.pad(t, ((0, 0), (WINDOW, WINDOW), (0, 0), (0, 0)))
        tp = tp.reshape(B, nb + 2, BLOCK, N_KV_HEADS, HEAD_DIM)
        return jnp.concatenate([tp[:, :-2], tp[:, 1:-1], tp[:, 2:]], axis=2)

    kb = band(k)
    vb = band(v)
    scale = 1.0 / math.sqrt(HEAD_DIM)
    scores = jnp.einsum('bnqkgd,bnskd->bnkgqs', qb, kb,
                        preferred_element_type=jnp.float32) * scale

    qi = jnp.arange(BLOCK)
    si = jnp.arange(3 * BLOCK)
    rel = si[None, :] - WINDOW - qi[:, None]
    dist = jnp.abs(rel).astype(jnp.float32)
    key_pos = jnp.arange(nb)[:, None] * BLOCK + si[None, :] - WINDOW
    valid = (jnp.abs(rel) <= WINDOW)[None, :, :] & ((key_pos >= 0) & (key_pos < S))[:, None, :]

    slopes = alibi_slopes().reshape(N_KV_HEADS, Q_PER_KV)
    scores = scores - slopes[:, :, None, None] * dist
    scores = jnp.where(valid[None, :, None, None], scores, NEG_BIG)

    sink = sink_logits.astype(jnp.float32).reshape(N_KV_HEADS, Q_PER_KV)[None, None, :, :, None, None]
    m = jnp.maximum(jnp.max(scores, axis=-1, keepdims=True), sink)
    p = jnp.exp(scores - m)
    denom = jnp.sum(p, axis=-1, keepdims=True) + jnp.exp(sink - m)
    probs = (p / denom).astype(v.dtype)
    out = jnp.einsum('bnkgqs,bnskd->bnqkgd', probs, vb)
    return out.reshape(B, S, ATTN_WIDTH)


def encoder_layer(x, w_in, w_fourier, sink_logits, w_out, ln_mix_g, ln_mix_b,
                  w_ff1, w_ff2, ln_ffn_g, ln_ffn_b):
    proj = x @ w_in
    c1 = FOURIER_WIDTH
    c2 = c1 + ATTN_WIDTH
    c3 = c2 + KV_WIDTH
    u = proj[..., :c1]
    q = proj[..., c1:c2]
    k = proj[..., c2:c3]
    v = proj[..., c3:]
    heads = jnp.concatenate([fourier_mix(u, w_fourier),
                             windowed_attention(q, k, v, sink_logits)], axis=-1)
    x = layer_norm(DEEPNORM_ALPHA * x + heads @ w_out, ln_mix_g, ln_mix_b)
    h = jnp.square(jax.nn.relu(x @ w_ff1))
    x = layer_norm(DEEPNORM_ALPHA * x + h @ w_ff2, ln_ffn_g, ln_ffn_b)
    return x


def trunk(x, ln_emb_g, ln_emb_b, w_in, w_fourier, sink_logits, w_out, ln_mix_g, ln_mix_b,
          w_ff1, w_ff2, ln_ffn_g, ln_ffn_b):
    x = layer_norm(x, ln_emb_g, ln_emb_b)
    for l in range(DEPTH):
        x = encoder_layer(x, w_in[l], w_fourier[l], sink_logits[l], w_out[l],
                          ln_mix_g[l], ln_mix_b[l], w_ff1[l], w_ff2[l],
                          ln_ffn_g[l], ln_ffn_b[l])
    return x


def setup_inputs(seed: int = 0) -> dict:
    key = jax.random.key(seed)
    ks = jax.random.split(key, 16)
    f32 = jnp.float32
    nrm = lambda k, shape, s: jax.random.normal(k, shape, f32) * s
    return {
        'x_prompt': nrm(ks[0], (BATCH, SEQ, D_MODEL), 1.0),
        'x_sample': nrm(ks[1], (DEC_BATCH, DEC_SEQ, D_MODEL), 1.0),
        'ln_emb_g': 1.0 + nrm(ks[2], (D_MODEL,), 0.02),
        'ln_emb_b': nrm(ks[3], (D_MODEL,), 0.02),
        'w_in': nrm(ks[4], (DEPTH, D_MODEL, IN_WIDTH), D_MODEL ** -0.5),
        'w_fourier': nrm(ks[5], (DEPTH, N_FOURIER_GROUPS, FOURIER_GROUP, FOURIER_GROUP), FOURIER_GROUP ** -0.5),
        'sink_logits': nrm(ks[6], (DEPTH, N_HEADS), 0.5),
        'w_out': nrm(ks[7], (DEPTH, MIX_WIDTH, D_MODEL), DEEPNORM_BETA * MIX_WIDTH ** -0.5),
        'ln_mix_g': 1.0 + nrm(ks[8], (DEPTH, D_MODEL), 0.02),
        'ln_mix_b': nrm(ks[9], (DEPTH, D_MODEL), 0.02),
        'w_ff1': nrm(ks[10], (DEPTH, D_MODEL, D_FF), D_MODEL ** -0.5),
        'w_ff2': nrm(ks[11], (DEPTH, D_FF, D_MODEL), DEEPNORM_BETA * D_FF ** -0.5),
        'ln_ffn_g': 1.0 + nrm(ks[12], (DEPTH, D_MODEL), 0.02),
        'ln_ffn_b': nrm(ks[13], (DEPTH, D_MODEL), 0.02),
    }


def reference(x_prompt, x_sample, ln_emb_g, ln_emb_b, w_in, w_fourier, sink_logits, w_out,
              ln_mix_g, ln_mix_b, w_ff1, w_ff2, ln_ffn_g, ln_ffn_b):
    y_prompt = trunk(x_prompt, ln_emb_g, ln_emb_b, w_in, w_fourier, sink_logits, w_out,
                     ln_mix_g, ln_mix_b, w_ff1, w_ff2, ln_ffn_g, ln_ffn_b)
    y_sample = trunk(x_sample, ln_emb_g, ln_emb_b, w_in, w_fourier, sink_logits, w_out,
                     ln_mix_g, ln_mix_b, w_ff1, w_ff2, ln_ffn_g, ln_ffn_b)
    return (y_prompt, y_sample)
```

```cpp
#include <hip/hip_runtime.h>
#include <hip/hip_cooperative_groups.h>
#include <cstdio>
#include <cstdint>
namespace cg = cooperative_groups;
namespace pg8 {
#define PG8_LAS __attribute__((address_space(3)))
typedef unsigned short bf16_t;
typedef short bf16x8 __attribute__((ext_vector_type(8)));
typedef float f32x4 __attribute__((ext_vector_type(4)));
typedef unsigned u32x4 __attribute__((ext_vector_type(4)));
constexpr int BM = 256, BK = 64, HALF = 128, HTB = HALF * BK * 2  , STAGE_BYTES = 8 * HTB, NXCD = 8, WGM = 8;

__host__ __device__ __forceinline__ int lds_byte(int r, int c) { const int st = (r >> 4) * 2 + (c >> 5), rr = r & 15, cc = c & 31, ob = rr * 64 + cc * 2; return st * 1024 + (ob ^ (((ob >> 9) & 1) << 5)); }
__host__ __device__ __forceinline__ void stage_rc(int b, int& R, int& C) { const int st = b / 1024, sb = b % 1024, swz = sb ^ (((sb >> 9) & 1) << 5); R = (st >> 1) * 16 + swz / 64; C = (st & 1) * 32 + (swz % 64) / 2; }
__host__ __device__ __forceinline__ int perm32(int rho) { const int n = rho >> 4, i = rho & 15; return 8 * (i >> 2) + 4 * n + (i & 3); }

struct Unit { int pm, pn; };
struct Gemm { const bf16_t* A; const bf16_t* Bt; int M, N, K; };

struct StaticOrder {
    int nM, nN, nwg, G, c;
    __host__ __device__ void init(int M, int N, int G_, int c_) { nM = M / BM; nN = N / BM; nwg = nM * nN; G = G_; c = c_; }
    __host__ __device__ bool next(int i, Unit& u) const {
        const long L = (long)i * G + c; if (L >= nwg) return false;
        int wgid = (int)L; { const int q = nwg / NXCD, r = nwg % NXCD, xcd = wgid % NXCD, off = wgid / NXCD; wgid = (xcd < r ? xcd * (q + 1) : r * (q + 1) + (xcd - r) * q) + off; }
        const int nig = WGM * nN, gid = wgid / nig, fm = gid * WGM, gsz = (nM - fm) < WGM ? (nM - fm) : WGM;
        u.pm = fm + ((wgid % nig) % gsz); u.pn = (wgid % nig) / gsz; return true;
    }
    __device__ __forceinline__ void a_ready(const Unit&) const {}
    __device__ __forceinline__ void done(const Unit&) const {}
};

__device__ __forceinline__ unsigned cvt_pk_bf16(float lo, float hi) { unsigned r; asm volatile("v_cvt_pk_bf16_f32 %0, %1, %2" : "=v"(r) : "v"(lo), "v"(hi)); return r; }
typedef float f32x2 __attribute__((ext_vector_type(2)));
__device__ __forceinline__ f32x2 gelu_pk(f32x2 v) {
    const f32x2 av = __builtin_elementwise_abs(v), d = av * 0.2316418882f + 1.0f;
    f32x2 t; t.x = __builtin_amdgcn_rcpf(d.x); t.y = __builtin_amdgcn_rcpf(d.y);
    f32x2 q = t * 0.5307027145f + (-0.7265760135f); q = q * t + 0.7107068705f; q = q * t + (-0.142248368f); q = q * t + 0.127414796f; q = q * t;
    const f32x2 s = (v * v) * (-0.72134752044f);
    f32x2 e; e.x = __builtin_amdgcn_exp2f(s.x); e.y = __builtin_amdgcn_exp2f(s.y);
    const f32x2 m = v * (q * e), r = v - m;
    f32x2 o; o.x = v.x < 0.f ? m.x : r.x; o.y = v.y < 0.f ? m.y : r.y; return o;
}

template <int ACT  > struct EpiBf16 {
    static constexpr bool PERM = true, AFTER_DRAIN = false; static_assert(ACT == 0 || ACT == 1 || ACT == 2, "EpiBf16: ACT is 0 (none), 1 (gelu_pk) or 2 (squared relu)");
    bf16_t* O; int ldc; const float* bias; int split_cols; size_t split_stride; float scale0;
    __device__ __forceinline__ void operator()(const f32x4 (&acc)[2][2][4][2], const Unit& u, int wr, int wc, int fr, int fq) const {
        const int row0 = u.pm * BM + wr * 64 + fr; int colt = u.pn * BM; bf16_t* base = O;
        float sc = 1.f; if (split_cols) { const int t = colt / split_cols; base += (size_t)t * split_stride; colt -= t * split_cols; if (t == 0) sc = scale0; }
        const int col0 = colt + wc * 32 + 8 * fq, bcol0 = u.pn * BM + wc * 32 + 8 * fq;
        f32x4 bv[2][2];
#pragma unroll
        for (int bj = 0; bj < 2; ++bj)
#pragma unroll
            for (int n = 0; n < 2; ++n) bv[bj][n] = bias ? *(const f32x4*)(bias + bcol0 + bj * HALF + 4 * n) : (f32x4){0.f, 0.f, 0.f, 0.f};
#pragma unroll
        for (int ai = 0; ai < 2; ++ai)
#pragma unroll
            for (int m = 0; m < 4; ++m) { bf16_t* rowp = base + (size_t)(row0 + ai * HALF + m * 16) * ldc + col0;
#pragma unroll
                for (int bj = 0; bj < 2; ++bj) { f32x4 v0 = acc[ai][bj][m][0] + bv[bj][0], v1 = acc[ai][bj][m][1] + bv[bj][1];
                    if (ACT == 1) { f32x2 a = gelu_pk((f32x2){v0[0], v0[1]}), b = gelu_pk((f32x2){v0[2], v0[3]}), c = gelu_pk((f32x2){v1[0], v1[1]}), d = gelu_pk((f32x2){v1[2], v1[3]});
                        v0 = (f32x4){a.x, a.y, b.x, b.y}; v1 = (f32x4){c.x, c.y, d.x, d.y}; }
                    if (ACT == 2) { v0 = __builtin_elementwise_max(v0, (f32x4){0.f,0.f,0.f,0.f}); v1 = __builtin_elementwise_max(v1, (f32x4){0.f,0.f,0.f,0.f}); v0 = v0 * v0; v1 = v1 * v1; }
                    v0 = v0 * sc; v1 = v1 * sc; u32x4 w; w.x = cvt_pk_bf16(v0[0], v0[1]); w.y = cvt_pk_bf16(v0[2], v0[3]); w.z = cvt_pk_bf16(v1[0], v1[1]); w.w = cvt_pk_bf16(v1[2], v1[3]);
                    *(u32x4*)(rowp + bj * HALF) = w; } }
    }
};

struct PanelStats {
    unsigned* xbuf;
    unsigned* cnt;
    unsigned* tmo;
    int ntn; float eps;
    unsigned code;
    __device__ __forceinline__ bool run(const f32x4 (&v)[2][2][4][2], const Unit& u, int wr, int wc, int fr, int fq, PG8_LAS unsigned char* lds, int wid, int lane) const {
        typedef float f32x2v __attribute__((ext_vector_type(2)));
        PG8_LAS f32x2v* P = (PG8_LAS f32x2v*)lds;
        PG8_LAS f32x2v* S = (PG8_LAS f32x2v*)(lds + 8192);
        PG8_LAS unsigned* flag = (PG8_LAS unsigned*)(lds + 8192 + 2048);
#pragma unroll
        for (int ai = 0; ai < 2; ++ai)
#pragma unroll
            for (int m = 0; m < 4; ++m) {
                float s = 0.f;
#pragma unroll
                for (int bj = 0; bj < 2; ++bj)
#pragma unroll
                    for (int n = 0; n < 2; ++n) { const f32x4 x = v[ai][bj][m][n]; s += (x[0] + x[1]) + (x[2] + x[3]); }
                s += __shfl_xor(s, 16); s += __shfl_xor(s, 32);
                const float mw = s * (1.0f / 64.0f); float q = 0.f;
#pragma unroll
                for (int bj = 0; bj < 2; ++bj)
#pragma unroll
                    for (int n = 0; n < 2; ++n) { const f32x4 d = v[ai][bj][m][n] - mw; q += (d[0] * d[0] + d[1] * d[1]) + (d[2] * d[2] + d[3] * d[3]); }
                q += __shfl_xor(q, 16); q += __shfl_xor(q, 32);
                if (fq == 0) P[(ai * HALF + wr * 64 + m * 16 + fr) * 4 + wc] = (f32x2v){mw, q};
            }
        asm volatile("s_waitcnt lgkmcnt(0)" ::: "memory"); __builtin_amdgcn_s_barrier(); asm volatile("" ::: "memory");
#if defined(BROKEN_EXCHANGE_NO_WAIT)
#warning BROKEN CONTROL BUILD: the row-statistics exchange does not wait; results are wrong by design
        if (blockIdx.x >= 64) { const long long t0_ = clock64(); while (clock64() - t0_ < 60000) __builtin_amdgcn_s_sleep(8); }
#endif
        const int row = wid * 32 + (lane & 31);
        if (lane < 32) {
            const f32x2v a = P[row * 4 + 0], b = P[row * 4 + 1], c = P[row * 4 + 2], d = P[row * 4 + 3];
            const float mt = (a.x + b.x + c.x + d.x) * 0.25f;
            const float da = a.x - mt, db = b.x - mt, dc = c.x - mt, dd = d.x - mt;
            const float m2 = (a.y + b.y) + (c.y + d.y) + 64.0f * ((da * da + db * db) + (dc * dc + dd * dd));
            unsigned long long* slot = (unsigned long long*)xbuf + ((size_t)(u.pm * BM + row) * 4 + u.pn);
            __hip_atomic_store(slot, ((unsigned long long)__float_as_uint(m2) << 32) | __float_as_uint(mt), __ATOMIC_RELAXED, __HIP_MEMORY_SCOPE_AGENT);
        }
        asm volatile("s_waitcnt vmcnt(0)" ::: "memory");
        if (lane == 0) __hip_atomic_fetch_add(cnt + 64 * u.pm, 1u, __ATOMIC_RELAXED, __HIP_MEMORY_SCOPE_AGENT);
        if (wid == 0) {
            bool dead = false; const unsigned long long t0 = __builtin_amdgcn_s_memrealtime(); const unsigned want = 8u * (unsigned)ntn;
            for (;;) {
#if defined(BROKEN_EXCHANGE_NO_WAIT)
                break;
#endif
                if ((unsigned)__builtin_amdgcn_readfirstlane(__hip_atomic_load(cnt + 64 * u.pm, __ATOMIC_RELAXED, __HIP_MEMORY_SCOPE_AGENT)) >= want) break;
                if (__builtin_amdgcn_s_memrealtime() - t0 > 2000000ull) {
                    if (lane == 0) { unsigned expect = 0u; __hip_atomic_compare_exchange_strong(tmo + 1, &expect, code | (unsigned)(u.pm & 0xff), __ATOMIC_RELAXED, __ATOMIC_RELAXED, __HIP_MEMORY_SCOPE_AGENT);
                                     __hip_atomic_store(tmo, 1u, __ATOMIC_RELAXED, __HIP_MEMORY_SCOPE_AGENT); }
                    dead = true; break; }
                __builtin_amdgcn_s_sleep(2);
            }
            __builtin_amdgcn_fence(__ATOMIC_ACQUIRE, "agent");
            if (lane == 0) flag[0] = dead ? 1u : 0u;
        }
        asm volatile("s_waitcnt vmcnt(0) lgkmcnt(0)" ::: "memory"); __builtin_amdgcn_s_barrier(); asm volatile("" ::: "memory");
        const bool bad = flag[0] != 0u;
        if (lane < 32) {
            const unsigned long long* slot = (const unsigned long long*)xbuf + (size_t)(u.pm * BM + row) * 4; float mt[4], m2[4]; float ms = 0.f;
#pragma unroll
            for (int t = 0; t < 4; ++t) { if (t < ntn) { const unsigned long long w = __hip_atomic_load(slot + t, __ATOMIC_RELAXED, __HIP_MEMORY_SCOPE_AGENT); mt[t] = __uint_as_float((unsigned)w); m2[t] = __uint_as_float((unsigned)(w >> 32)); } else { mt[t] = 0.f; m2[t] = 0.f; } ms += mt[t]; }
            const float mean = ms / (float)ntn; float q = 0.f;
#pragma unroll
            for (int t = 0; t < 4; ++t) if (t < ntn) { const float dm = mt[t] - mean; q += m2[t] + 256.0f * dm * dm; }
            S[row] = (f32x2v){mean, 1.0f / sqrtf(q / (256.0f * (float)ntn) + eps)};
        }
        asm volatile("s_waitcnt lgkmcnt(0)" ::: "memory"); __builtin_amdgcn_s_barrier(); asm volatile("" ::: "memory");
        return bad;
    }
};
struct EpiLnRes {
    static constexpr bool PERM = false, AFTER_DRAIN = true;
    const float* base; float* out; int ldc; const float* bias; PanelStats st; unsigned poison;
    __device__ __forceinline__ void fused(f32x4 (&acc)[2][2][4][2], const Unit& u, int wr, int wc, int fr, int fq, PG8_LAS unsigned char* lds, int wid, int lane) const {
        typedef float f32x2v __attribute__((ext_vector_type(2)));
        const PG8_LAS f32x2v* S = (const PG8_LAS f32x2v*)(lds + 8192);
        const int col0 = u.pn * BM + wc * 32 + 4 * fq;
#pragma unroll
        for (int bj = 0; bj < 2; ++bj)
#pragma unroll
            for (int n = 0; n < 2; ++n) { const f32x4 bv = bias ? *(const f32x4*)(bias + col0 + bj * HALF + n * 16) : (f32x4){0.f, 0.f, 0.f, 0.f};
#pragma unroll
                for (int ai = 0; ai < 2; ++ai)
#pragma unroll
                    for (int m = 0; m < 4; ++m) acc[ai][bj][m][n] += bv; }
        f32x4 pre[4][2][2];
#pragma unroll
        for (int m = 0; m < 4; ++m) { const size_t off = (size_t)(u.pm * BM + wr * 64 + m * 16 + fr) * ldc + col0;
#pragma unroll
            for (int bj = 0; bj < 2; ++bj)
#pragma unroll
                for (int n = 0; n < 2; ++n) pre[m][bj][n] = *(const f32x4*)(base + off + bj * HALF + n * 16); }
        const bool bad = st.run(acc, u, wr, wc, fr, fq, lds, wid, lane) || poison != 0u;
        const float qnan = __builtin_nanf("");
#pragma unroll
        for (int ai = 0; ai < 2; ++ai)
#pragma unroll
            for (int m = 0; m < 4; ++m) { const int r = ai * HALF + wr * 64 + m * 16 + fr; const f32x2v sr = S[r]; const size_t off = (size_t)(u.pm * BM + r) * ldc + col0;
#pragma unroll
                for (int bj = 0; bj < 2; ++bj)
#pragma unroll
                    for (int n = 0; n < 2; ++n) { const f32x4 bs = ai == 0 ? pre[m][bj][n] : *(const f32x4*)(base + off + bj * HALF + n * 16); f32x4 o = bs + (acc[ai][bj][m][n] - sr.x) * sr.y;
                        if (bad) o = (f32x4){qnan, qnan, qnan, qnan}; *(f32x4*)(out + off + bj * HALF + n * 16) = o; }
                if (m & 1) asm volatile("" ::: "memory"); }
    }
};
struct EpiLnResLn {
    static constexpr bool PERM = false, AFTER_DRAIN = true;
    const float* base; float* out; bf16_t* xn; int ldc; const float* bias; PanelStats st1, st2; unsigned poison;
    __device__ __forceinline__ void fused(f32x4 (&acc)[2][2][4][2], const Unit& u, int wr, int wc, int fr, int fq, PG8_LAS unsigned char* lds, int wid, int lane) const {
        typedef float f32x2v __attribute__((ext_vector_type(2))); typedef unsigned u32x2v __attribute__((ext_vector_type(2)));
        const PG8_LAS f32x2v* S = (const PG8_LAS f32x2v*)(lds + 8192);
        const int col0 = u.pn * BM + wc * 32 + 4 * fq;
#pragma unroll
        for (int bj = 0; bj < 2; ++bj)
#pragma unroll
            for (int n = 0; n < 2; ++n) { const f32x4 bv = bias ? *(const f32x4*)(bias + col0 + bj * HALF + n * 16) : (f32x4){0.f, 0.f, 0.f, 0.f};
#pragma unroll
                for (int ai = 0; ai < 2; ++ai)
#pragma unroll
                    for (int m = 0; m < 4; ++m) acc[ai][bj][m][n] += bv; }
        bool bad = st1.run(acc, u, wr, wc, fr, fq, lds, wid, lane) || poison != 0u;
        const float qnan = __builtin_nanf("");
#pragma unroll
        for (int ai = 0; ai < 2; ++ai)
#pragma unroll
            for (int m = 0; m < 4; ++m) { const int r = ai * HALF + wr * 64 + m * 16 + fr; const f32x2v sr = S[r]; const size_t off = (size_t)(u.pm * BM + r) * ldc + col0;
#pragma unroll
                for (int bj = 0; bj < 2; ++bj)
#pragma unroll
                    for (int n = 0; n < 2; ++n) { const f32x4 bs = *(const f32x4*)(base + off + bj * HALF + n * 16); acc[ai][bj][m][n] = bs + (acc[ai][bj][m][n] - sr.x) * sr.y; }
                asm volatile("" : "+v"(acc[ai][0][m][0]), "+v"(acc[ai][0][m][1]), "+v"(acc[ai][1][m][0]), "+v"(acc[ai][1][m][1]));
                if (m & 1) asm volatile("" ::: "memory"); }
        const bool bad1 = bad;
        bad = st2.run(acc, u, wr, wc, fr, fq, lds, wid, lane) || bad;
#pragma unroll
        for (int ai = 0; ai < 2; ++ai)
#pragma unroll
            for (int m = 0; m < 4; ++m) { const int r = ai * HALF + wr * 64 + m * 16 + fr; const f32x2v sr = S[r]; const size_t off = (size_t)(u.pm * BM + r) * ldc + col0;
#pragma unroll
                for (int bj = 0; bj < 2; ++bj)
#pragma unroll
                    for (int n = 0; n < 2; ++n) { const f32x4 x1 = acc[ai][bj][m][n]; *(f32x4*)(out + off + bj * HALF + n * 16) = bad1 ? (f32x4){qnan, qnan, qnan, qnan} : x1;
                        const f32x4 o = (x1 - sr.x) * sr.y; u32x2v w; w.x = cvt_pk_bf16(o[0], o[1]); w.y = cvt_pk_bf16(o[2], o[3]);
                        if (bad) { w.x = 0x7fc07fc0u; w.y = 0x7fc07fc0u; } *(u32x2v*)(xn + off + bj * HALF + n * 16) = w; }
                asm volatile("" ::: "memory"); }
    }
};

template <class Epi, class Sched, bool ALIGN_EPI = false, bool SP2 = false>
__device__ __forceinline__ void gemm_phase(PG8_LAS unsigned char* lds, const Gemm g, const Sched& S, const Epi& E) {
    int tid_ = threadIdx.x; asm volatile("" : "+v"(tid_));
    const int tid = tid_, wid = __builtin_amdgcn_readfirstlane(tid >> 6), lane = tid & 63, wr = wid >> 2, wc = wid & 3, fr = lane & 15, fq = lane >> 4;
    const int K = g.K, nt = K / BK;
    unsigned voffA[2], voffB[2];
#pragma unroll
    for (int i = 0; i < 2; ++i) { int R, C; stage_rc(tid * 16 + i * 8192, R, C); const int Rb = Epi::PERM ? ((R & ~31) + perm32(R & 31)) : R;
        voffA[i] = (unsigned)(R * K + C) * 2u; voffB[i] = (unsigned)(Rb * K + C) * 2u; }
    const size_t kstep = (size_t)(BK * 2);
    const size_t hstep = (size_t)HALF * K * 2;
    const size_t tstep = 2 * hstep;
    const unsigned ldsw = (unsigned)wid * 1024u;
    const int aoff = lds_byte(wr * 64 + fr, fq * 8), boff = lds_byte(wc * 32 + fr, fq * 8);
#define PG8_SA(b, h) (((b) * 2 + (h)) * HTB)
#define PG8_SB(b, h) ((4 + (b) * 2 + (h)) * HTB)
#define PG8_STAGE(bufoff, gbase, voff) do { _Pragma("unroll") for (int _i = 0; _i < 2; ++_i) \
        __builtin_amdgcn_global_load_lds((const unsigned*)((const char*)(gbase) + (voff)[_i]), (PG8_LAS unsigned*)(lds + (bufoff) + ldsw + _i * 8192), 16, 0, 0); } while (0)
#define PG8_LDA(dst, b, h) do { _Pragma("unroll") for (int m = 0; m < 4; ++m) _Pragma("unroll") for (int k = 0; k < 2; ++k) dst[m][k] = *(const PG8_LAS bf16x8*)(lds + PG8_SA(b, h) + aoff + m * 2048 + k * 1024); } while (0)
#define PG8_LDB(dst, b, h) do { _Pragma("unroll") for (int n = 0; n < 2; ++n) _Pragma("unroll") for (int k = 0; k < 2; ++k) dst[n][k] = *(const PG8_LAS bf16x8*)(lds + PG8_SB(b, h) + boff + n * 2048 + k * 1024); } while (0)
#define PG8_MMA(ai, bj, At, Bt) do { __builtin_amdgcn_s_setprio(1); _Pragma("unroll") for (int m = 0; m < 4; ++m) _Pragma("unroll") for (int n = 0; n < 2; ++n) _Pragma("unroll") for (int k = 0; k < 2; ++k) \
        acc[ai][bj][m][n] = __builtin_amdgcn_mfma_f32_16x16x32_bf16(Bt[n][k], At[m][k], acc[ai][bj][m][n], 0, 0, 0); __builtin_amdgcn_s_setprio(0); } while (0)
#define PG8_WAIT_V(n) asm volatile("s_waitcnt vmcnt(" #n ")" ::: "memory")
#define PG8_WAIT_L(n) asm volatile("s_waitcnt lgkmcnt(" #n ")" ::: "memory")
#define PG8_BAR __builtin_amdgcn_s_barrier()
#define PG8_SCHED __builtin_amdgcn_sched_barrier(0)
    Unit cur, nxt; int ui = 0;
    if (!S.next(0, cur)) return;
    f32x4 acc[2][2][4][2];
#pragma unroll
    for (int a = 0; a < 2; ++a)
#pragma unroll
        for (int b = 0; b < 2; ++b)
#pragma unroll
            for (int m = 0; m < 4; ++m)
#pragma unroll
                for (int n = 0; n < 2; ++n) acc[a][b][m][n] = (f32x4){0.f, 0.f, 0.f, 0.f};
    bf16x8 At[4][2], B0[2][2], B1[2][2];
    const char* cA = (const char*)g.A + (size_t)cur.pm * tstep; const char* cB = (const char*)g.Bt + (size_t)cur.pn * tstep;
    S.a_ready(cur);
    if constexpr (SP2) {
        PG8_STAGE(PG8_SB(0, 0), cB, voffB); PG8_STAGE(PG8_SB(0, 1), cB + hstep, voffB); PG8_STAGE(PG8_SA(0, 0), cA, voffA); PG8_STAGE(PG8_SA(0, 1), cA + hstep, voffA);
        if (wr == 1) PG8_BAR;
        PG8_WAIT_V(2); PG8_BAR;
        PG8_STAGE(PG8_SB(1, 0), cB + kstep, voffB); PG8_STAGE(PG8_SA(1, 0), cA + kstep, voffA); PG8_STAGE(PG8_SB(1, 1), cB + hstep + kstep, voffB);
        PG8_WAIT_V(6); PG8_BAR;
    } else {
        PG8_STAGE(PG8_SB(0, 0), cB, voffB); PG8_STAGE(PG8_SA(0, 0), cA, voffA); PG8_STAGE(PG8_SB(0, 1), cB + hstep, voffB); PG8_STAGE(PG8_SA(0, 1), cA + hstep, voffA);
        if (wr == 1) PG8_BAR;
        PG8_WAIT_V(4); PG8_BAR;
        PG8_STAGE(PG8_SB(1, 0), cB + kstep, voffB); PG8_STAGE(PG8_SA(1, 0), cA + kstep, voffA); PG8_STAGE(PG8_SB(1, 1), cB + hstep + kstep, voffB);
        PG8_WAIT_V(6); PG8_BAR;
    }
    for (;;) {
        const bool has_next = S.next(ui + 1, nxt);
        const char* nA = has_next ? (const char*)g.A + (size_t)nxt.pm * tstep : cA; const char* nB = has_next ? (const char*)g.Bt + (size_t)nxt.pn * tstep : cB;
        for (int t = 0; t < nt; t += 2) {
            const bool last = (t == nt - 2);
            const char* a1 = cA + (size_t)(t + 1) * kstep;
            const char* a2 = last ? nA : cA + (size_t)(t + 2) * kstep; const char* b2 = last ? nB : cB + (size_t)(t + 2) * kstep;
            const char* a3 = a2 + kstep; const char* b3 = b2 + kstep;
            if (last && has_next) S.a_ready(nxt);
            if constexpr (SP2) {
            PG8_LDB(B0, 0, 0); PG8_LDB(B1, 0, 1); PG8_SCHED; PG8_LDA(At, 0, 0); PG8_STAGE(PG8_SA(1, 1), a1 + hstep, voffA);
            PG8_WAIT_V(8); PG8_WAIT_L(0); PG8_BAR; PG8_MMA(0, 0, At, B0); PG8_MMA(0, 1, At, B1); PG8_BAR; PG8_SCHED;
            PG8_LDA(At, 0, 1); PG8_STAGE(PG8_SB(0, 0), b2, voffB); PG8_STAGE(PG8_SB(0, 1), b2 + hstep, voffB); PG8_STAGE(PG8_SA(0, 0), a2, voffA);
            PG8_WAIT_V(8); PG8_WAIT_L(0); PG8_BAR; PG8_MMA(1, 0, At, B0); PG8_MMA(1, 1, At, B1); PG8_BAR; PG8_SCHED;
            PG8_LDB(B0, 1, 0); PG8_LDB(B1, 1, 1); PG8_SCHED; PG8_LDA(At, 1, 0); PG8_STAGE(PG8_SA(0, 1), a2 + hstep, voffA);
            PG8_WAIT_V(8); PG8_WAIT_L(0); PG8_BAR; PG8_MMA(0, 0, At, B0); PG8_MMA(0, 1, At, B1); PG8_BAR; PG8_SCHED;
            PG8_LDA(At, 1, 1); PG8_STAGE(PG8_SB(1, 0), b3, voffB); PG8_STAGE(PG8_SB(1, 1), b3 + hstep, voffB); PG8_STAGE(PG8_SA(1, 0), a3, voffA);
            PG8_WAIT_V(8); PG8_WAIT_L(0); PG8_BAR; PG8_MMA(1, 0, At, B0); PG8_MMA(1, 1, At, B1); PG8_BAR; PG8_SCHED;
            } else {
            PG8_LDB(B0, 0, 0); PG8_SCHED; PG8_LDA(At, 0, 0); PG8_STAGE(PG8_SA(1, 1), a1 + hstep, voffA);
            PG8_WAIT_L(8); PG8_BAR; PG8_WAIT_L(0); PG8_MMA(0, 0, At, B0); PG8_BAR; PG8_SCHED;
            PG8_LDB(B1, 0, 1); PG8_STAGE(PG8_SB(0, 0), b2, voffB);
            PG8_BAR; PG8_WAIT_L(0); PG8_MMA(0, 1, At, B1); PG8_BAR;
            PG8_LDA(At, 0, 1); PG8_STAGE(PG8_SA(0, 0), a2, voffA);
            PG8_BAR; PG8_WAIT_L(0); PG8_MMA(1, 0, At, B0); PG8_BAR; PG8_SCHED;
            PG8_STAGE(PG8_SB(0, 1), b2 + hstep, voffB);
            PG8_WAIT_V(6); PG8_BAR; PG8_MMA(1, 1, At, B1); PG8_BAR;
            PG8_LDB(B0, 1, 0); PG8_SCHED; PG8_LDA(At, 1, 0); PG8_STAGE(PG8_SA(0, 1), a2 + hstep, voffA);
            PG8_WAIT_L(8); PG8_BAR; PG8_WAIT_L(0); PG8_MMA(0, 0, At, B0); PG8_BAR; PG8_SCHED;
            PG8_LDB(B1, 1, 1); PG8_STAGE(PG8_SB(1, 0), b3, voffB);
            PG8_BAR; PG8_WAIT_L(0); PG8_MMA(0, 1, At, B1); PG8_BAR;
            PG8_LDA(At, 1, 1); PG8_STAGE(PG8_SA(1, 0), a3, voffA);
            PG8_BAR; PG8_WAIT_L(0); PG8_MMA(1, 0, At, B0); PG8_BAR; PG8_SCHED;
            PG8_STAGE(PG8_SB(1, 1), b3 + hstep, voffB);
            PG8_WAIT_V(6); PG8_BAR; PG8_MMA(1, 1, At, B1); PG8_BAR;
            }
        }
        if constexpr (ALIGN_EPI) { if (wr == 0) PG8_BAR; }
        if constexpr (!Epi::AFTER_DRAIN) { E(acc, cur, wr, wc, fr, fq); S.done(cur); }
        if (!has_next) break;
#pragma unroll
        for (int a = 0; a < 2; ++a)
#pragma unroll
            for (int b = 0; b < 2; ++b)
#pragma unroll
                for (int m = 0; m < 4; ++m)
#pragma unroll
                    for (int n = 0; n < 2; ++n) acc[a][b][m][n] = (f32x4){0.f, 0.f, 0.f, 0.f};
        cur = nxt; cA = nA; cB = nB; ++ui;
        if constexpr (ALIGN_EPI) { if (wr == 1) PG8_BAR; }
    }
    PG8_WAIT_V(0);
    if constexpr (!ALIGN_EPI) { if (wr == 0) PG8_BAR; }
    PG8_BAR;
    if constexpr (Epi::AFTER_DRAIN) { E.fused(acc, cur, wr, wc, fr, fq, lds, wid, lane); S.done(cur); }
#undef PG8_SA
#undef PG8_SB
#undef PG8_STAGE
#undef PG8_LDA
#undef PG8_LDB
#undef PG8_MMA
#undef PG8_WAIT_V
#undef PG8_WAIT_L
#undef PG8_BAR
#undef PG8_SCHED
}
}

namespace pg8 {
struct EpiRes {
    static constexpr bool PERM = true, AFTER_DRAIN = false;
    const bf16_t* X; bf16_t* O; int ldc; float alpha;
    __device__ __forceinline__ void operator()(const f32x4 (&acc)[2][2][4][2], const Unit& u, int wr, int wc, int fr, int fq) const {
        const int row0 = u.pm * BM + wr * 64 + fr, col0 = u.pn * BM + wc * 32 + 8 * fq;
#pragma unroll
        for (int ai = 0; ai < 2; ++ai)
#pragma unroll
            for (int m = 0; m < 4; ++m) { const size_t off = (size_t)(row0 + ai * HALF + m * 16) * ldc + col0;
#pragma unroll
                for (int bj = 0; bj < 2; ++bj) { const u32x4 xv = *(const u32x4*)(X + off + bj * HALF);
                    f32x4 x0, x1;
                    x0[0] = __uint_as_float(xv.x << 16); x0[1] = __uint_as_float(xv.x & 0xffff0000u); x0[2] = __uint_as_float(xv.y << 16); x0[3] = __uint_as_float(xv.y & 0xffff0000u);
                    x1[0] = __uint_as_float(xv.z << 16); x1[1] = __uint_as_float(xv.z & 0xffff0000u); x1[2] = __uint_as_float(xv.w << 16); x1[3] = __uint_as_float(xv.w & 0xffff0000u);
                    const f32x4 v0 = x0 * alpha + acc[ai][bj][m][0], v1 = x1 * alpha + acc[ai][bj][m][1];
                    u32x4 w; w.x = cvt_pk_bf16(v0[0], v0[1]); w.y = cvt_pk_bf16(v0[2], v0[3]); w.z = cvt_pk_bf16(v1[0], v1[1]); w.w = cvt_pk_bf16(v1[2], v1[3]);
                    *(u32x4*)(O + off + bj * HALF) = w; } }
    }
};
}

#define LAS __attribute__((address_space(3)))
typedef unsigned short bf16;
typedef short bf16x8 __attribute__((ext_vector_type(8)));
typedef short s16x4 __attribute__((ext_vector_type(4)));
typedef float f32x4 __attribute__((ext_vector_type(4)));
typedef float f32x16 __attribute__((ext_vector_type(16)));
typedef unsigned u32x4 __attribute__((ext_vector_type(4)));
typedef unsigned u32x2 __attribute__((ext_vector_type(2)));

constexpr int DM = 1024, MP = 65536, MS = 16384, MTOK = MP + MS, SP = 4096, SS = 16384, DFF = 4096;
constexpr int NPROJ = 1792;
constexpr int INW = 1280;
constexpr float LN_EPS = 1e-5f;
constexpr float ALPHA = 1.4142135623730951f;
constexpr float LOG2E = 1.4426950408889634f;
constexpr int NWAVES = 8, NTHR = 512;
constexpr int LDS_BYTES = 147456;

constexpr size_t MiB = 1u << 20;
constexpr size_t WS_TAB = 1 * MiB;
constexpr size_t T_A1P = 0, T_A1S = 32768, T_A2P = 163840, T_A2S = 180224, T_TWP = 245760, T_TWS = 278528;
constexpr size_t WS_W = 2 * MiB, W_LAYER = 22 * MiB, W_IN = 0, W_OUT = 4 * MiB, W_FF1 = 6 * MiB, W_FF2 = 14 * MiB;
constexpr size_t WS_X = 48 * MiB, WS_Z = 208 * MiB, WS_H = 368 * MiB, WS_PROJ = 368 * MiB, WS_END = 1008 * MiB;

__device__ __forceinline__ unsigned f2bf(float f) { unsigned u = __builtin_bit_cast(unsigned, f); return (u + 0x7fffu + ((u >> 16) & 1u)) >> 16; }
__device__ __forceinline__ unsigned pk2(float lo, float hi) { return f2bf(lo) | (f2bf(hi) << 16); }
__device__ __forceinline__ float bflo(unsigned u) { return __uint_as_float(u << 16); }
__device__ __forceinline__ float bfhi(unsigned u) { return __uint_as_float(u & 0xffff0000u); }
__device__ __forceinline__ float wave_sum(float v) {
#pragma unroll
    for (int o = 1; o < 64; o <<= 1) v += __shfl_xor(v, o);
    return v;
}
__device__ __forceinline__ s16x4 vtr(const LAS unsigned char* p) { return __builtin_bit_cast(s16x4, __builtin_amdgcn_ds_read_tr16_b64_v4i16((LAS s16x4*)p)); }
__device__ __forceinline__ bf16x8 cat8(s16x4 lo, s16x4 hi) { return (bf16x8){lo[0], lo[1], lo[2], lo[3], hi[0], hi[1], hi[2], hi[3]}; }
#define LDS_WAIT() asm volatile("s_waitcnt lgkmcnt(0)" ::: "memory")

__device__ __forceinline__ void p0_transpose_item(const float* W, int ldw, int col_off, int ncols, int K, bf16* WT, int row_off, LAS float* scr, int item, int lane) {
    const int nblk = ncols / 32, kb = item / nblk, nb = item % nblk, k0 = 64 * kb, n0 = 32 * nb;
#pragma unroll 8
    for (int i = 0; i < 32; ++i) { const int kk = 2 * i + (lane >> 5); scr[kk * 33 + (lane & 31)] = W[(size_t)(k0 + kk) * ldw + col_off + n0 + (lane & 31)]; }
    LDS_WAIT(); asm volatile("" ::: "memory");
    const int c = lane & 7;
#pragma unroll
    for (int j = 0; j < 4; ++j) { const int n = (lane >> 3) + 8 * j; const LAS float* s = scr + (8 * c) * 33 + n;
        u32x4 o; o.x = pk2(s[0 * 33], s[1 * 33]); o.y = pk2(s[2 * 33], s[3 * 33]); o.z = pk2(s[4 * 33], s[5 * 33]); o.w = pk2(s[6 * 33], s[7 * 33]);
        *(u32x4*)(WT + (size_t)(row_off + n0 + n) * K + k0 + 8 * c) = o; }
    LDS_WAIT(); asm volatile("" ::: "memory");
}
__device__ __forceinline__ void ln_emb_row(const float* xrow, const float* g, const float* b, bf16* orow, int lane) {
    const f32x4* xr = (const f32x4*)xrow + lane;
    f32x4 v[4]; float s = 0.f;
#pragma unroll
    for (int j = 0; j < 4; ++j) { v[j] = xr[64 * j]; s += (v[j].x + v[j].y) + (v[j].z + v[j].w); }
    const float mean = wave_sum(s) * (1.f / DM); float s2 = 0.f;
#pragma unroll
    for (int j = 0; j < 4; ++j) { v[j] = v[j] - mean; s2 += (v[j].x * v[j].x + v[j].y * v[j].y) + (v[j].z * v[j].z + v[j].w * v[j].w); }
    const float rstd = 1.f / sqrtf(wave_sum(s2) * (1.f / DM) + LN_EPS);
    u32x2* o8 = (u32x2*)orow + lane;
#pragma unroll
    for (int j = 0; j < 4; ++j) { const f32x4 gg = ((const f32x4*)g)[lane + 64 * j], bb = ((const f32x4*)b)[lane + 64 * j]; const f32x4 y = v[j] * rstd * gg + bb;
        u32x2 w; w.x = pk2(y.x, y.y); w.y = pk2(y.z, y.w); o8[64 * j] = w; }
}
__device__ __forceinline__ void fold_task(LAS unsigned char* lds, const float* w_in_l, const float* wf_l, bf16* wt_in_l, int task, int tid) {
    LAS float* tab = (LAS float*)lds;
    LAS float* Mt = (LAS float*)(lds + 1024);
    LAS float* At = (LAS float*)(lds + 1024 + 32768);
    const int kt = task >> 4, cb = task & 15, g = cb >> 2, ri = (cb >> 1) & 1, eh = cb & 1;
    if (tid < 128) tab[tid] = cospif((float)tid * (1.0f / 64.0f));
    for (int i = tid; i < 64 * 128; i += NTHR) { const int kk = i >> 7, c = i & 127; At[kk * 129 + c] = w_in_l[(size_t)(64 * kt + kk) * INW + g * 128 + c]; }
    __syncthreads();
    {
        const int e = eh * 64 + (tid & 63), c0 = (tid >> 6) * 16; const int off = ri ? 32 : 0;
        float acc[16];
#pragma unroll
        for (int j = 0; j < 16; ++j) acc[j] = 0.f;
        const float* wf = wf_l + (size_t)g * 128 * 128 + e;
        for (int d = 0; d < 128; ++d) { const float w = wf[d * 128];
#pragma unroll
            for (int j = 0; j < 16; ++j) acc[j] += tab[((c0 + j) * d + off) & 127] * w; }
#pragma unroll
        for (int j = 0; j < 16; ++j) Mt[(c0 + j) * 64 + (tid & 63)] = acc[j] * 0.08838834764831845f;
    }
    __syncthreads();
    {
        const int kk = tid & 63, e0 = (tid >> 6) * 8; float acc[8];
#pragma unroll
        for (int j = 0; j < 8; ++j) acc[j] = 0.f;
        for (int c = 0; c < 128; ++c) { const float a = At[kk * 129 + c]; const f32x4 m0 = *(const LAS f32x4*)(Mt + c * 64 + e0), m1 = *(const LAS f32x4*)(Mt + c * 64 + e0 + 4);
            acc[0] += a * m0.x; acc[1] += a * m0.y; acc[2] += a * m0.z; acc[3] += a * m0.w; acc[4] += a * m1.x; acc[5] += a * m1.y; acc[6] += a * m1.z; acc[7] += a * m1.w; }
#pragma unroll
        for (int j = 0; j < 8; ++j) wt_in_l[(size_t)(ri * 512 + g * 128 + eh * 64 + e0 + j) * DM + 64 * kt + kk] = (bf16)f2bf(acc[j]);
    }
    __syncthreads();
}
__device__ __forceinline__ void make_tables(unsigned char* tabs, int gtid, int gthreads) {
    bf16* A1P = (bf16*)(tabs + T_A1P); bf16* A1S = (bf16*)(tabs + T_A1S); bf16* A2P = (bf16*)(tabs + T_A2P); bf16* A2S = (bf16*)(tabs + T_A2S);
    float2* TWP = (float2*)(tabs + T_TWP); float2* TWS = (float2*)(tabs + T_TWS);
    for (int i = gtid; i < 128 * 128; i += gthreads) {
        const int m = i >> 7, k = i & 127, k1 = m & 63, s1 = k & 63; const float x = (float)((k1 * s1) & 63) * (1.0f / 32.0f);
        const float c = cospif(x) * 0.125f, s = sinpif(x) * 0.125f; const int im = m >> 6, vi = k >> 6;
        A1P[i] = (bf16)f2bf(im == 0 ? (vi == 0 ? c : s) : (vi == 0 ? -s : c)); }
    for (int i = gtid; i < 256 * 256; i += gthreads) {
        const int m = i >> 8, k = i & 255, k1 = m & 127, s1 = k & 127; const float x = (float)((k1 * s1) & 127) * (1.0f / 64.0f);
        const float sc = 0.08838834764831845f; const float c = cospif(x) * sc, s = sinpif(x) * sc; const int im = m >> 7, vi = k >> 7;
        A1S[i] = (bf16)f2bf(im == 0 ? (vi == 0 ? c : s) : (vi == 0 ? -s : c)); }
    for (int i = gtid; i < 64 * 128; i += gthreads) {
        const int k2 = i >> 7, k = i & 127, s2 = k & 63; const float x = (float)((k2 * s2) & 63) * (1.0f / 32.0f);
        A2P[i] = (bf16)f2bf((k >> 6) == 0 ? cospif(x) * 0.125f : sinpif(x) * 0.125f); }
    for (int i = gtid; i < 128 * 256; i += gthreads) {
        const int k2 = i >> 8, k = i & 255, s2 = k & 127; const float x = (float)((k2 * s2) & 127) * (1.0f / 64.0f); const float sc = 0.08838834764831845f;
        A2S[i] = (bf16)f2bf((k >> 7) == 0 ? cospif(x) * sc : sinpif(x) * sc); }
    for (int i = gtid; i < 64 * 64; i += gthreads) {
        const int s2 = i >> 6, k1 = i & 63; const float x = (float)(s2 * k1) * (1.0f / 2048.0f); TWP[i] = make_float2(cospif(x), -sinpif(x)); }
    for (int i = gtid; i < 128 * 128; i += gthreads) {
        const int s2 = i >> 7, k1 = i & 127; const float x = (float)(s2 * k1) * (1.0f / 8192.0f); TWS[i] = make_float2(cospif(x), -sinpif(x)); }
}

template <int N1>
__device__ __forceinline__ void fft1_task(LAS unsigned char* lds, const bf16* PROJ, bf16* ZP, const bf16* A1, const float2* TW, size_t row_base, int s2, int g, int tid) {
    constexpr int K2 = 2 * N1, RS = 320;
    for (int c = tid; c < K2 * 16; c += NTHR) { const int r = c >> 4, ch = c & 15, s1 = r & (N1 - 1), im = r / N1;
        const u32x4 v = *(const u32x4*)(PROJ + (row_base + (size_t)s1 * N1 + s2) * NPROJ + im * 512 + g * 128 + ch * 8);
        *(LAS u32x4*)(lds + r * RS + ch * 16) = v; }
    __syncthreads();
    const int lane = tid & 63, w = tid >> 6, h = lane >> 5, c32 = lane & 31, i16 = lane & 15;
    const int troff = (8 * h + (i16 >> 2)) * RS + (16 * ((lane >> 4) & 1) + 4 * (i16 & 3)) * 2;
    constexpr int NPAIR = (N1 / 32) * 4;
    for (int pi = w; pi < NPAIR; pi += NWAVES) {
        const int nt = pi & 3, mi = pi >> 2;
        f32x16 are, aim;
#pragma unroll
        for (int r = 0; r < 16; ++r) { are[r] = 0.f; aim[r] = 0.f; }
        const bf16* arp = A1 + (size_t)(32 * mi + c32) * K2 + 8 * h;
        const bf16* aip = arp + (size_t)N1 * K2;
        const LAS unsigned char* tb = lds + troff + nt * 64;
#pragma unroll 4
        for (int ks = 0; ks < K2 / 16; ++ks) {
            const s16x4 lo = vtr(tb + ks * 16 * RS), hi = vtr(tb + ks * 16 * RS + 4 * RS);
            const bf16x8 bfr = cat8(lo, hi);
            const bf16x8 ar = *(const bf16x8*)(arp + ks * 16), ai = *(const bf16x8*)(aip + ks * 16);
            are = __builtin_amdgcn_mfma_f32_32x32x16_bf16(ar, bfr, are, 0, 0, 0);
            aim = __builtin_amdgcn_mfma_f32_32x32x16_bf16(ai, bfr, aim, 0, 0, 0);
        }
#pragma unroll
        for (int r = 0; r < 16; ++r) { const int k1 = 32 * mi + (r & 3) + 8 * (r >> 2) + 4 * h; const float2 t = TW[s2 * N1 + k1];
            const float zr = are[r] * t.x - aim[r] * t.y, zi = are[r] * t.y + aim[r] * t.x;
            bf16* o = ZP + (row_base + (size_t)k1 * N1 + s2) * DM + g * 128 + nt * 32 + c32;
            o[0] = (bf16)f2bf(zr); o[512] = (bf16)f2bf(zi); }
    }
    __syncthreads();
}
template <int N2>
__device__ __forceinline__ void fft2_task(LAS unsigned char* lds, const bf16* ZP, bf16* HEADS, const bf16* A2, size_t row_base, int k1, int g, int tid) {
    constexpr int K2 = 2 * N2, RS = 320;
    for (int c = tid; c < K2 * 16; c += NTHR) { const int r = c >> 4, ch = c & 15, s2 = r & (N2 - 1), im = r / N2;
        const u32x4 v = *(const u32x4*)(ZP + (row_base + (size_t)k1 * N2 + s2) * DM + im * 512 + g * 128 + ch * 8);
        *(LAS u32x4*)(lds + r * RS + ch * 16) = v; }
    __syncthreads();
    const int lane = tid & 63, w = tid >> 6, h = lane >> 5, c32 = lane & 31, i16 = lane & 15;
    const int troff = (8 * h + (i16 >> 2)) * RS + (16 * ((lane >> 4) & 1) + 4 * (i16 & 3)) * 2;
    constexpr int NTILE = (N2 / 32) * 4;
    for (int ti = w; ti < NTILE; ti += NWAVES) {
        const int nt = ti & 3, mi = ti >> 2;
        f32x16 acc;
#pragma unroll
        for (int r = 0; r < 16; ++r) acc[r] = 0.f;
        const bf16* ap = A2 + (size_t)(32 * mi + c32) * K2 + 8 * h;
        const LAS unsigned char* tb = lds + troff + nt * 64;
#pragma unroll 4
        for (int ks = 0; ks < K2 / 16; ++ks) {
            const s16x4 lo = vtr(tb + ks * 16 * RS), hi = vtr(tb + ks * 16 * RS + 4 * RS);
            const bf16x8 bfr = cat8(lo, hi);
            const bf16x8 a = *(const bf16x8*)(ap + ks * 16);
            acc = __builtin_amdgcn_mfma_f32_32x32x16_bf16(a, bfr, acc, 0, 0, 0);
        }
#pragma unroll
        for (int r = 0; r < 16; ++r) { const int k2 = 32 * mi + (r & 3) + 8 * (r >> 2) + 4 * h;
            HEADS[(row_base + (size_t)k1 + (size_t)N2 * k2) * DM + g * 128 + nt * 32 + c32] = (bf16)f2bf(acc[r]); }
    }
    __syncthreads();
}

__device__ __forceinline__ unsigned cvtpk(float lo, float hi) { typedef float f2 __attribute__((ext_vector_type(2))); typedef __bf16 b2 __attribute__((ext_vector_type(2))); f2 v = {lo, hi}; b2 b = __builtin_convertvector(v, b2); return __builtin_bit_cast(unsigned, b); }
__device__ __forceinline__ void attn_task(LAS unsigned char* lds, const bf16* PROJ, bf16* HEADS, const float* sink, size_t row_base, int S, int n, int kv, int tid) {
    constexpr int KRS = 144, VT = 384 * 64;
    LAS unsigned char* Kl = lds; LAS unsigned char* Vl = lds + 384 * KRS;
    const int nb = S / 128;
    for (int c = tid; c < 384 * 8; c += NTHR) { const int si = c >> 3, ch = c & 7, kp = n * 128 - 128 + si;
        u32x4 kk = {0u, 0u, 0u, 0u}, vv = {0u, 0u, 0u, 0u};
        if (kp >= 0 && kp < S) { const bf16* src = PROJ + (row_base + (size_t)kp) * NPROJ + 1536 + kv * 64 + ch * 8; kk = *(const u32x4*)src; vv = *(const u32x4*)(src + 128); }
        *(LAS u32x4*)(Kl + si * KRS + ch * 16) = kk;
        *(LAS u32x4*)(Vl + (ch >> 2) * VT + si * 64 + (ch & 3) * 16) = vv; }
    __syncthreads();
    const int lane = tid & 63, w = tid >> 6, h = lane >> 5, c32 = lane & 31, i16 = lane & 15;
    const int lo_valid = (n == 0) ? 128 : 0, hi_valid = (n == nb - 1) ? 256 : 384;
    const int vtoff = (4 * h + (i16 >> 2)) * 64 + (16 * ((lane >> 4) & 1) + 4 * (i16 & 3)) * 2;
    for (int qt = w; qt < 16; qt += NWAVES) {
        const int hh = qt >> 2, qo = 32 * (qt & 3), head = kv * 4 + hh, qi = qo + c32;
        const float slope2 = __builtin_amdgcn_exp2f(-(float)(head + 1)) * LOG2E;
        const size_t qrow = row_base + (size_t)n * 128 + qi;
        bf16x8 qf[4];
#pragma unroll
        for (int ds = 0; ds < 4; ++ds) qf[ds] = *(const bf16x8*)(PROJ + qrow * NPROJ + 1024 + head * 64 + 16 * ds + 8 * h);
        float m = sink[head] * LOG2E, l = (h == 0) ? 1.f : 0.f;
        f32x16 o0, o1;
#pragma unroll
        for (int r = 0; r < 16; ++r) { o0[r] = 0.f; o1[r] = 0.f; }
        for (int kt = 0; kt < 9; ++kt) {
            const int si0 = qo + 32 * kt;
            if (si0 + 31 < lo_valid || si0 >= hi_valid) continue;
            f32x16 s;
#pragma unroll
            for (int r = 0; r < 16; ++r) s[r] = 0.f;
#pragma unroll
            for (int ds = 0; ds < 4; ++ds) { const bf16x8 kf = *(const LAS bf16x8*)(Kl + (si0 + c32) * KRS + (16 * ds + 8 * h) * 2); s = __builtin_amdgcn_mfma_f32_32x32x16_bf16(kf, qf[ds], s, 0, 0, 0); }
            float mx = m;
#pragma unroll
            for (int r = 0; r < 16; ++r) { const int si = si0 + (r & 3) + 8 * (r >> 2) + 4 * h; const int rel = si - 128 - qi; const int d = rel < 0 ? -rel : rel;
                const bool ok = (d <= 128) && (si >= lo_valid) && (si < hi_valid);
                float t = s[r] * (0.125f * LOG2E) - slope2 * (float)d; t = ok ? t : -1e30f; s[r] = t; mx = fmaxf(mx, t); }
            mx = fmaxf(mx, __shfl_xor(mx, 32));
            const float alpha = __builtin_amdgcn_exp2f(m - mx); m = mx;
            float ps = 0.f;
#pragma unroll
            for (int r = 0; r < 16; ++r) { const float p = __builtin_amdgcn_exp2f(s[r] - mx); s[r] = p; ps += p; }
            l = l * alpha + ps;
#pragma unroll
            for (int r = 0; r < 16; ++r) { o0[r] *= alpha; o1[r] *= alpha; }
            u32x4 p0, p1;
            p0.x = cvtpk(s[0], s[1]); p0.y = cvtpk(s[2], s[3]); p0.z = cvtpk(s[4], s[5]); p0.w = cvtpk(s[6], s[7]);
            p1.x = cvtpk(s[8], s[9]); p1.y = cvtpk(s[10], s[11]); p1.z = cvtpk(s[12], s[13]); p1.w = cvtpk(s[14], s[15]);
            const bf16x8 pf0 = __builtin_bit_cast(bf16x8, p0), pf1 = __builtin_bit_cast(bf16x8, p1);
            const LAS unsigned char* vb = Vl + si0 * 64 + vtoff;
            {   const bf16x8 v00 = cat8(vtr(vb), vtr(vb + 8 * 64)), v01 = cat8(vtr(vb + 16 * 64), vtr(vb + 24 * 64));
                o0 = __builtin_amdgcn_mfma_f32_32x32x16_bf16(v00, pf0, o0, 0, 0, 0); o0 = __builtin_amdgcn_mfma_f32_32x32x16_bf16(v01, pf1, o0, 0, 0, 0); }
            {   const bf16x8 v10 = cat8(vtr(vb + VT), vtr(vb + VT + 8 * 64)), v11 = cat8(vtr(vb + VT + 16 * 64), vtr(vb + VT + 24 * 64));
                o1 = __builtin_amdgcn_mfma_f32_32x32x16_bf16(v10, pf0, o1, 0, 0, 0); o1 = __builtin_amdgcn_mfma_f32_32x32x16_bf16(v11, pf1, o1, 0, 0, 0); }
        }
        l += __shfl_xor(l, 32);
        const float inv = 1.0f / l;
        bf16* orow = HEADS + qrow * DM + 512 + head * 64 + 4 * h;
#pragma unroll
        for (int r4 = 0; r4 < 4; ++r4) {
            u32x2 a, b; a.x = cvtpk(o0[4 * r4] * inv, o0[4 * r4 + 1] * inv); a.y = cvtpk(o0[4 * r4 + 2] * inv, o0[4 * r4 + 3] * inv);
            b.x = cvtpk(o1[4 * r4] * inv, o1[4 * r4 + 1] * inv); b.y = cvtpk(o1[4 * r4 + 2] * inv, o1[4 * r4 + 3] * inv);
            *(u32x2*)(orow + 8 * r4) = a; *(u32x2*)(orow + 32 + 8 * r4) = b; }
    }
    __syncthreads();
}

__device__ __forceinline__ void ln_pass(const bf16* Z, const float* gam, const float* bet, bf16* Xo, float* Fo, int gw, int ngw, int lane) {
    f32x4 g0 = ((const f32x4*)gam)[2 * lane], g1 = ((const f32x4*)gam)[2 * lane + 1], g2 = ((const f32x4*)gam)[128 + 2 * lane], g3 = ((const f32x4*)gam)[128 + 2 * lane + 1];
    f32x4 b0 = ((const f32x4*)bet)[2 * lane], b1 = ((const f32x4*)bet)[2 * lane + 1], b2 = ((const f32x4*)bet)[128 + 2 * lane], b3 = ((const f32x4*)bet)[128 + 2 * lane + 1];
    for (int m = gw; m < MTOK; m += ngw) {
        const u32x4 a = *(const u32x4*)(Z + (size_t)m * DM + 8 * lane), c = *(const u32x4*)(Z + (size_t)m * DM + 512 + 8 * lane);
        f32x4 v0 = {bflo(a.x), bfhi(a.x), bflo(a.y), bfhi(a.y)}, v1 = {bflo(a.z), bfhi(a.z), bflo(a.w), bfhi(a.w)};
        f32x4 v2 = {bflo(c.x), bfhi(c.x), bflo(c.y), bfhi(c.y)}, v3 = {bflo(c.z), bfhi(c.z), bflo(c.w), bfhi(c.w)};
        f32x4 t = (v0 + v1) + (v2 + v3);
        const float mean = wave_sum((t.x + t.y) + (t.z + t.w)) * (1.f / DM);
        v0 = v0 - mean; v1 = v1 - mean; v2 = v2 - mean; v3 = v3 - mean;
        t = (v0 * v0 + v1 * v1) + (v2 * v2 + v3 * v3);
        const float rstd = 1.f / sqrtf(wave_sum((t.x + t.y) + (t.z + t.w)) * (1.f / DM) + LN_EPS);
        v0 = v0 * rstd * g0 + b0; v1 = v1 * rstd * g1 + b1; v2 = v2 * rstd * g2 + b2; v3 = v3 * rstd * g3 + b3;
        if (Fo) { f32x4* o = (f32x4*)(Fo + (size_t)m * DM + 8 * lane); o[0] = v0; o[1] = v1; o[128] = v2; o[129] = v3; }
        else { u32x4 w0, w1; w0.x = pk2(v0.x, v0.y); w0.y = pk2(v0.z, v0.w); w0.z = pk2(v1.x, v1.y); w0.w = pk2(v1.z, v1.w);
            w1.x = pk2(v2.x, v2.y); w1.y = pk2(v2.z, v2.w); w1.z = pk2(v3.x, v3.y); w1.w = pk2(v3.z, v3.w);
            *(u32x4*)(Xo + (size_t)m * DM + 8 * lane) = w0; *(u32x4*)(Xo + (size_t)m * DM + 512 + 8 * lane) = w1; }
    }
}

struct Args { const float* in[14]; float* out; unsigned char* ws; int ph_lo, ph_hi; };
constexpr int NPHASE = 17;
typedef const __attribute__((address_space(4))) Args* ArgsP;
__device__ __forceinline__ ArgsP get_args() { ArgsP p = (ArgsP)__builtin_amdgcn_kernarg_segment_ptr(); asm volatile("" : "+s"(p)); return p; }
#define WSP(ap, off) ((ap)->ws + (off))
#define XBUF(ap) ((bf16*)WSP(ap, WS_X))
#define ZBUF(ap) ((bf16*)WSP(ap, WS_Z))
#define HBUF(ap) ((bf16*)WSP(ap, WS_H))
#define PROJBUF(ap) ((bf16*)WSP(ap, WS_PROJ))
#define ZPBUF(ap) ((bf16*)(ap)->out)
#define HEADSBUF(ap) ((bf16*)(ap)->out + (size_t)MTOK * DM)
#define TABS(ap) WSP(ap, WS_TAB)
#define WL(ap, L, off) ((const bf16*)WSP(ap, WS_W + (size_t)(L) * W_LAYER + (off)))
__global__ void __launch_bounds__(NTHR, 2) hymba_fwd(Args args_unused) {
    extern __shared__ __attribute__((aligned(16))) unsigned char lds_raw[];
    LAS unsigned char* lds = (LAS unsigned char*)lds_raw;
    cg::grid_group grid = cg::this_grid();
    const int G = gridDim.x, bx = blockIdx.x;
#define FRESH() int tid = threadIdx.x; asm volatile("" : "+v"(tid)); const int lane = tid & 63, wave = __builtin_amdgcn_readfirstlane(tid >> 6); (void)lane; (void)wave;
#define IN(k) (get_args()->ph_lo <= (k) && (k) < get_args()->ph_hi)
#define SEAM(k) do { if (IN(k) && IN((k) + 1)) grid.sync(); } while (0)

    if (IN(0)) {
        FRESH(); ArgsP ap = get_args();
        for (int t = bx; t < 512; t += G) { const int L = t >> 8;
            fold_task(lds, ap->in[4] + (size_t)L * DM * INW, ap->in[5] + (size_t)L * 4 * 128 * 128, (bf16*)WL(ap, L, W_IN), t & 255, tid); }
        LAS float* scr = (LAS float*)(lds + wave * 16384);
        const int gw = bx * NWAVES + wave, ngw = G * NWAVES;
        constexpr int I_QKV = 16 * 24, I_O = 16 * 32, I_1 = 16 * 128, I_2 = 64 * 32, I_L = I_QKV + I_O + I_1 + I_2;
        for (int it = gw; it < 2 * I_L; it += ngw) {
            const int L = it / I_L; int r = it % I_L;
            if (r < I_QKV) { p0_transpose_item(ap->in[4] + (size_t)L * DM * INW, INW, 512, 768, DM, (bf16*)WL(ap, L, W_IN), 1024, scr, r, lane); continue; } r -= I_QKV;
            if (r < I_O) { p0_transpose_item(ap->in[7] + (size_t)L * DM * DM, DM, 0, DM, DM, (bf16*)WL(ap, L, W_OUT), 0, scr, r, lane); continue; } r -= I_O;
            if (r < I_1) { p0_transpose_item(ap->in[10] + (size_t)L * DM * DFF, DFF, 0, DFF, DM, (bf16*)WL(ap, L, W_FF1), 0, scr, r, lane); continue; } r -= I_1;
            p0_transpose_item(ap->in[11] + (size_t)L * DFF * DM, DM, 0, DM, DFF, (bf16*)WL(ap, L, W_FF2), 0, scr, r, lane);
        }
        { const float* x_prompt = ap->in[0]; const float* x_sample = ap->in[1]; const float* eg = ap->in[2]; const float* eb = ap->in[3]; bf16* X = XBUF(ap);
          for (int m = gw; m < MTOK; m += ngw) { const float* xr = m < MP ? x_prompt + (size_t)m * DM : x_sample + (size_t)(m - MP) * DM; ln_emb_row(xr, eg, eb, X + (size_t)m * DM, lane); } }
        make_tables(TABS(ap), bx * NTHR + tid, G * NTHR);
    }
    SEAM(0);
    for (int L = 0; L < 2; ++L) {
        const int pb = 1 + 8 * L;
        if (IN(pb + 0)) {
            ArgsP ap = get_args();
            pg8::Gemm g{XBUF(ap), WL(ap, L, W_IN), MTOK, NPROJ, DM}; pg8::StaticOrder S; S.init(MTOK, NPROJ, G, bx);
            pg8::EpiBf16<0> E{PROJBUF(ap), NPROJ, nullptr, 0, 0, 1.f};
            pg8::gemm_phase<pg8::EpiBf16<0>, pg8::StaticOrder, true, true>(lds, g, S, E);
        }
        SEAM(pb + 0);
        if (IN(pb + 1)) {
            FRESH(); ArgsP ap = get_args();
            const float* sink = ap->in[6] + L * 8; const bf16* PROJ = PROJBUF(ap); bf16* HEADS = HEADSBUF(ap); bf16* ZP = ZPBUF(ap); const unsigned char* tabs = TABS(ap);
            constexpr int NATT = 1280, NF1P = 4096, NF1S = 512;
            for (int t = bx; t < NATT + NF1P + NF1S; t += G) {
                if (t < NATT) {
                    if (t < 1024) { const int kv = t & 1, n = (t >> 1) & 31, b = t >> 6; attn_task(lds, PROJ, HEADS, sink, (size_t)b * SP, SP, n, kv, tid); }
                    else { const int u = t - 1024, kv = u & 1, n = u >> 1; attn_task(lds, PROJ, HEADS, sink, (size_t)MP, SS, n, kv, tid); }
                } else if (t < NATT + NF1P) { const int u = t - NATT, g = u & 3, s2 = (u >> 2) & 63, b = u >> 8;
                    fft1_task<64>(lds, PROJ, ZP, (const bf16*)(tabs + T_A1P), (const float2*)(tabs + T_TWP), (size_t)b * SP, s2, g, tid);
                } else { const int u = t - NATT - NF1P, g = u & 3, s2 = u >> 2;
                    fft1_task<128>(lds, PROJ, ZP, (const bf16*)(tabs + T_A1S), (const float2*)(tabs + T_TWS), (size_t)MP, s2, g, tid); }
            }
        }
        SEAM(pb + 1);
        if (IN(pb + 2)) {
            FRESH(); ArgsP ap = get_args();
            const bf16* ZP = ZPBUF(ap); bf16* HEADS = HEADSBUF(ap); const unsigned char* tabs = TABS(ap);
            for (int t = bx; t < 4096 + 512; t += G) {
                if (t < 4096) { const int g = t & 3, k1 = (t >> 2) & 63, b = t >> 8; fft2_task<64>(lds, ZP, HEADS, (const bf16*)(tabs + T_A2P), (size_t)b * SP, k1, g, tid); }
                else { const int u = t - 4096, g = u & 3, k1 = u >> 2; fft2_task<128>(lds, ZP, HEADS, (const bf16*)(tabs + T_A2S), (size_t)MP, k1, g, tid); }
            }
        }
        SEAM(pb + 2);
        if (IN(pb + 3)) {
            ArgsP ap = get_args();
            pg8::Gemm g{HEADSBUF(ap), WL(ap, L, W_OUT), MTOK, DM, DM}; pg8::StaticOrder S; S.init(MTOK, DM, G, bx);
            pg8::EpiRes E{XBUF(ap), ZBUF(ap), DM, ALPHA};
            pg8::gemm_phase<pg8::EpiRes, pg8::StaticOrder, true, true>(lds, g, S, E);
        }
        SEAM(pb + 3);
        if (IN(pb + 4)) { FRESH(); ArgsP ap = get_args(); ln_pass(ZBUF(ap), ap->in[8] + L * DM, ap->in[9] + L * DM, XBUF(ap), nullptr, bx * NWAVES + wave, G * NWAVES, lane); }
        SEAM(pb + 4);
        if (IN(pb + 5)) {
            ArgsP ap = get_args();
            pg8::Gemm g{XBUF(ap), WL(ap, L, W_FF1), MTOK, DFF, DM}; pg8::StaticOrder S; S.init(MTOK, DFF, G, bx);
            pg8::EpiBf16<2> E{HBUF(ap), DFF, nullptr, 0, 0, 1.f};
            pg8::gemm_phase<pg8::EpiBf16<2>, pg8::StaticOrder, true, true>(lds, g, S, E);
        }
        SEAM(pb + 5);
        if (IN(pb + 6)) {
            ArgsP ap = get_args();
            pg8::Gemm g{HBUF(ap), WL(ap, L, W_FF2), MTOK, DM, DFF}; pg8::StaticOrder S; S.init(MTOK, DM, G, bx);
            pg8::EpiRes E{XBUF(ap), ZBUF(ap), DM, ALPHA};
            pg8::gemm_phase<pg8::EpiRes, pg8::StaticOrder, true, true>(lds, g, S, E);
        }
        SEAM(pb + 6);
        if (IN(pb + 7)) { FRESH(); ArgsP ap = get_args(); ln_pass(ZBUF(ap), ap->in[12] + L * DM, ap->in[13] + L * DM, XBUF(ap), L == 1 ? ap->out : nullptr, bx * NWAVES + wave, G * NWAVES, lane); }
        if (L == 0) SEAM(pb + 7);
    }
#undef IN
#undef SEAM
}

#ifndef MK_ONE_LAUNCH
#define MK_ONE_LAUNCH 1
#endif
extern "C" void kernel_launch(void* const* d_in, const int* in_sizes, int n_in, void* d_out, int out_size, void* d_ws, size_t ws_size, hipStream_t stream) {
    static int grid = 0;
    if (grid == 0) {
        if (n_in != 14 || out_size != MTOK * DM || ws_size < WS_END) { fprintf(stderr, "kernel_launch: unexpected shapes (n_in %d, out %d, ws %zu); nothing launched\n", n_in, out_size, ws_size); grid = -1; return; }
        int dev = 0, cus = 0, per_cu = 0;
        hipGetDevice(&dev); hipDeviceGetAttribute(&cus, hipDeviceAttributeMultiprocessorCount, dev);
        if (hipFuncSetAttribute((const void*)hymba_fwd, hipFuncAttributeMaxDynamicSharedMemorySize, LDS_BYTES) != hipSuccess) { fprintf(stderr, "kernel_launch: hipFuncSetAttribute failed\n"); grid = -1; return; }
        if (hipOccupancyMaxActiveBlocksPerMultiprocessor(&per_cu, (const void*)hymba_fwd, NTHR, LDS_BYTES) != hipSuccess || per_cu < 1) { fprintf(stderr, "kernel_launch: occupancy query says %d\n", per_cu); per_cu = 1; }
        (void)hipGetLastError();
        grid = cus * per_cu;
        fprintf(stderr, "kernel_launch: grid %d (%d CUs x %d)\n", grid, cus, per_cu);
    }
    if (grid < 0) return;
    Args a{};
    for (int i = 0; i < 14; ++i) a.in[i] = (const float*)d_in[i];
    a.out = (float*)d_out; a.ws = (unsigned char*)d_ws;
#if MK_ONE_LAUNCH
    a.ph_lo = 0; a.ph_hi = NPHASE;
    void* kargs[] = {&a};
    hipError_t e = hipLaunchCooperativeKernel((const void*)hymba_fwd, dim3(grid), dim3(NTHR), kargs, LDS_BYTES, stream);
    if (e != hipSuccess) fprintf(stderr, "kernel_launch: cooperative launch failed: %s (grid %d)\n", hipGetErrorString(e), grid);
#else
    for (int p = 0; p < NPHASE; ++p) { a.ph_lo = p; a.ph_hi = p + 1; hipLaunchKernelGGL(hymba_fwd, dim3(grid), dim3(NTHR), LDS_BYTES, stream, a); }
#endif
}
```

```cpp
#include <hip/hip_runtime.h>
#include <hip/hip_cooperative_groups.h>
#include <cstdio>
#include <cstdint>
namespace cg = cooperative_groups;
namespace pg8 {
#define PG8_LAS __attribute__((address_space(3)))
typedef unsigned short bf16_t;
typedef short bf16x8 __attribute__((ext_vector_type(8)));
typedef float f32x4 __attribute__((ext_vector_type(4)));
typedef unsigned u32x4 __attribute__((ext_vector_type(4)));
constexpr int BM = 256, BK = 64, HALF = 128, HTB = HALF * BK * 2  , STAGE_BYTES = 8 * HTB, NXCD = 8, WGM = 8;

__host__ __device__ __forceinline__ int lds_byte(int r, int c) { const int st = (r >> 4) * 2 + (c >> 5), rr = r & 15, cc = c & 31, ob = rr * 64 + cc * 2; return st * 1024 + (ob ^ (((ob >> 9) & 1) << 5)); }
__host__ __device__ __forceinline__ void stage_rc(int b, int& R, int& C) { const int st = b / 1024, sb = b % 1024, swz = sb ^ (((sb >> 9) & 1) << 5); R = (st >> 1) * 16 + swz / 64; C = (st & 1) * 32 + (swz % 64) / 2; }
__host__ __device__ __forceinline__ int perm32(int rho) { const int n = rho >> 4, i = rho & 15; return 8 * (i >> 2) + 4 * n + (i & 3); }

struct Unit { int pm, pn; };
struct Gemm { const bf16_t* A; const bf16_t* Bt; int M, N, K; };

struct StaticOrder {
    int nM, nN, nwg, G, c;
    __host__ __device__ void init(int M, int N, int G_, int c_) { nM = M / BM; nN = N / BM; nwg = nM * nN; G = G_; c = c_; }
    __host__ __device__ bool next(int i, Unit& u) const {
        const long L = (long)i * G + c; if (L >= nwg) return false;
        int wgid = (int)L; { const int q = nwg / NXCD, r = nwg % NXCD, xcd = wgid % NXCD, off = wgid / NXCD; wgid = (xcd < r ? xcd * (q + 1) : r * (q + 1) + (xcd - r) * q) + off; }
        const int nig = WGM * nN, gid = wgid / nig, fm = gid * WGM, gsz = (nM - fm) < WGM ? (nM - fm) : WGM;
        u.pm = fm + ((wgid % nig) % gsz); u.pn = (wgid % nig) / gsz; return true;
    }
    __device__ __forceinline__ void a_ready(const Unit&) const {}
    __device__ __forceinline__ void done(const Unit&) const {}
};

__device__ __forceinline__ unsigned cvt_pk_bf16(float lo, float hi) { unsigned r; asm volatile("v_cvt_pk_bf16_f32 %0, %1, %2" : "=v"(r) : "v"(lo), "v"(hi)); return r; }
typedef float f32x2 __attribute__((ext_vector_type(2)));
__device__ __forceinline__ f32x2 gelu_pk(f32x2 v) {
    const f32x2 av = __builtin_elementwise_abs(v), d = av * 0.2316418882f + 1.0f;
    f32x2 t; t.x = __builtin_amdgcn_rcpf(d.x); t.y = __builtin_amdgcn_rcpf(d.y);
    f32x2 q = t * 0.5307027145f + (-0.7265760135f); q = q * t + 0.7107068705f; q = q * t + (-0.142248368f); q = q * t + 0.127414796f; q = q * t;
    const f32x2 s = (v * v) * (-0.72134752044f);
    f32x2 e; e.x = __builtin_amdgcn_exp2f(s.x); e.y = __builtin_amdgcn_exp2f(s.y);
    const f32x2 m = v * (q * e), r = v - m;
    f32x2 o; o.x = v.x < 0.f ? m.x : r.x; o.y = v.y < 0.f ? m.y : r.y; return o;
}

template <int ACT  > struct EpiBf16 {
    static constexpr bool PERM = true, AFTER_DRAIN = false; static_assert(ACT == 0 || ACT == 1 || ACT == 2, "EpiBf16: ACT is 0 (none), 1 (gelu_pk) or 2 (squared relu)");
    bf16_t* O; int ldc; const float* bias; int split_cols; size_t split_stride; float scale0;
    __device__ __forceinline__ void operator()(const f32x4 (&acc)[2][2][4][2], const Unit& u, int wr, int wc, int fr, int fq) const {
        const int row0 = u.pm * BM + wr * 64 + fr; int colt = u.pn * BM; bf16_t* base = O;
        float sc = 1.f; if (split_cols) { const int t = colt / split_cols; base += (size_t)t * split_stride; colt -= t * split_cols; if (t == 0) sc = scale0; }
        const int col0 = colt + wc * 32 + 8 * fq, bcol0 = u.pn * BM + wc * 32 + 8 * fq;
        f32x4 bv[2][2];
#pragma unroll
        for (int bj = 0; bj < 2; ++bj)
#pragma unroll
            for (int n = 0; n < 2; ++n) bv[bj][n] = bias ? *(const f32x4*)(bias + bcol0 + bj * HALF + 4 * n) : (f32x4){0.f, 0.f, 0.f, 0.f};
#pragma unroll
        for (int ai = 0; ai < 2; ++ai)
#pragma unroll
            for (int m = 0; m < 4; ++m) { bf16_t* rowp = base + (size_t)(row0 + ai * HALF + m * 16) * ldc + col0;
#pragma unroll
                for (int bj = 0; bj < 2; ++bj) { f32x4 v0 = acc[ai][bj][m][0] + bv[bj][0], v1 = acc[ai][bj][m][1] + bv[bj][1];
                    if (ACT == 1) { f32x2 a = gelu_pk((f32x2){v0[0], v0[1]}), b = gelu_pk((f32x2){v0[2], v0[3]}), c = gelu_pk((f32x2){v1[0], v1[1]}), d = gelu_pk((f32x2){v1[2], v1[3]});
                        v0 = (f32x4){a.x, a.y, b.x, b.y}; v1 = (f32x4){c.x, c.y, d.x, d.y}; }
                    if (ACT == 2) { v0 = __builtin_elementwise_max(v0, (f32x4){0.f,0.f,0.f,0.f}); v1 = __builtin_elementwise_max(v1, (f32x4){0.f,0.f,0.f,0.f}); v0 = v0 * v0; v1 = v1 * v1; }
                    v0 = v0 * sc; v1 = v1 * sc; u32x4 w; w.x = cvt_pk_bf16(v0[0], v0[1]); w.y = cvt_pk_bf16(v0[2], v0[3]); w.z = cvt_pk_bf16(v1[0], v1[1]); w.w = cvt_pk_bf16(v1[2], v1[3]);
                    *(u32x4*)(rowp + bj * HALF) = w; } }
    }
};

struct PanelStats {
    unsigned* xbuf;
    unsigned* cnt;
    unsigned* tmo;
    int ntn; float eps;
    unsigned code;
    __device__ __forceinline__ bool run(const f32x4 (&v)[2][2][4][2], const Unit& u, int wr, int wc, int fr, int fq, PG8_LAS unsigned char* lds, int wid, int lane) const {
        typedef float f32x2v __attribute__((ext_vector_type(2)));
        PG8_LAS f32x2v* P = (PG8_LAS f32x2v*)lds;
        PG8_LAS f32x2v* S = (PG8_LAS f32x2v*)(lds + 8192);
        PG8_LAS unsigned* flag = (PG8_LAS unsigned*)(lds + 8192 + 2048);
#pragma unroll
        for (int ai = 0; ai < 2; ++ai)
#pragma unroll
            for (int m = 0; m < 4; ++m) {
                float s = 0.f;
#pragma unroll
                for (int bj = 0; bj < 2; ++bj)
#pragma unroll
                    for (int n = 0; n < 2; ++n) { const f32x4 x = v[ai][bj][m][n]; s += (x[0] + x[1]) + (x[2] + x[3]); }
                s += __shfl_xor(s, 16); s += __shfl_xor(s, 32);
                const float mw = s * (1.0f / 64.0f); float q = 0.f;
#pragma unroll
                for (int bj = 0; bj < 2; ++bj)
#pragma unroll
                    for (int n = 0; n < 2; ++n) { const f32x4 d = v[ai][bj][m][n] - mw; q += (d[0] * d[0] + d[1] * d[1]) + (d[2] * d[2] + d[3] * d[3]); }
                q += __shfl_xor(q, 16); q += __shfl_xor(q, 32);
                if (fq == 0) P[(ai * HALF + wr * 64 + m * 16 + fr) * 4 + wc] = (f32x2v){mw, q};
            }
        asm volatile("s_waitcnt lgkmcnt(0)" ::: "memory"); __builtin_amdgcn_s_barrier(); asm volatile("" ::: "memory");
#if defined(BROKEN_EXCHANGE_NO_WAIT)
#warning BROKEN CONTROL BUILD: the row-statistics exchange does not wait; results are wrong by design
        if (blockIdx.x >= 64) { const long long t0_ = clock64(); while (clock64() - t0_ < 60000) __builtin_amdgcn_s_sleep(8); }
#endif
        const int row = wid * 32 + (lane & 31);
        if (lane < 32) {
            const f32x2v a = P[row * 4 + 0], b = P[row * 4 + 1], c = P[row * 4 + 2], d = P[row * 4 + 3];
            const float mt = (a.x + b.x + c.x + d.x) * 0.25f;
            const float da = a.x - mt, db = b.x - mt, dc = c.x - mt, dd = d.x - mt;
            const float m2 = (a.y + b.y) + (c.y + d.y) + 64.0f * ((da * da + db * db) + (dc * dc + dd * dd));
            unsigned long long* slot = (unsigned long long*)xbuf + ((size_t)(u.pm * BM + row) * 4 + u.pn);
            __hip_atomic_store(slot, ((unsigned long long)__float_as_uint(m2) << 32) | __float_as_uint(mt), __ATOMIC_RELAXED, __HIP_MEMORY_SCOPE_AGENT);
        }
        asm volatile("s_waitcnt vmcnt(0)" ::: "memory");
        if (lane == 0) __hip_atomic_fetch_add(cnt + 64 * u.pm, 1u, __ATOMIC_RELAXED, __HIP_MEMORY_SCOPE_AGENT);
        if (wid == 0) {
            bool dead = false; const unsigned long long t0 = __builtin_amdgcn_s_memrealtime(); const unsigned want = 8u * (unsigned)ntn;
            for (;;) {
#if defined(BROKEN_EXCHANGE_NO_WAIT)
                break;
#endif
                if ((unsigned)__builtin_amdgcn_readfirstlane(__hip_atomic_load(cnt + 64 * u.pm, __ATOMIC_RELAXED, __HIP_MEMORY_SCOPE_AGENT)) >= want) break;
                if (__builtin_amdgcn_s_memrealtime() - t0 > 2000000ull) {
                    if (lane == 0) { unsigned expect = 0u; __hip_atomic_compare_exchange_strong(tmo + 1, &expect, code | (unsigned)(u.pm & 0xff), __ATOMIC_RELAXED, __ATOMIC_RELAXED, __HIP_MEMORY_SCOPE_AGENT);
                                     __hip_atomic_store(tmo, 1u, __ATOMIC_RELAXED, __HIP_MEMORY_SCOPE_AGENT); }
                    dead = true; break; }
                __builtin_amdgcn_s_sleep(2);
            }
            __builtin_amdgcn_fence(__ATOMIC_ACQUIRE, "agent");
            if (lane == 0) flag[0] = dead ? 1u : 0u;
        }
        asm volatile("s_waitcnt vmcnt(0) lgkmcnt(0)" ::: "memory"); __builtin_amdgcn_s_barrier(); asm volatile("" ::: "memory");
        const bool bad = flag[0] != 0u;
        if (lane < 32) {
            const unsigned long long* slot = (const unsigned long long*)xbuf + (size_t)(u.pm * BM + row) * 4; float mt[4], m2[4]; float ms = 0.f;
#pragma unroll
            for (int t = 0; t < 4; ++t) { if (t < ntn) { const unsigned long long w = __hip_atomic_load(slot + t, __ATOMIC_RELAXED, __HIP_MEMORY_SCOPE_AGENT); mt[t] = __uint_as_float((unsigned)w); m2[t] = __uint_as_float((unsigned)(w >> 32)); } else { mt[t] = 0.f; m2[t] = 0.f; } ms += mt[t]; }
            const float mean = ms / (float)ntn; float q = 0.f;
#pragma unroll
            for (int t = 0; t < 4; ++t) if (t < ntn) { const float dm = mt[t] - mean; q += m2[t] + 256.0f * dm * dm; }
            S[row] = (f32x2v){mean, 1.0f / sqrtf(q / (256.0f * (float)ntn) + eps)};
        }
        asm volatile("s_waitcnt lgkmcnt(0)" ::: "memory"); __builtin_amdgcn_s_barrier(); asm volatile("" ::: "memory");
        return bad;
    }
};
struct EpiLnRes {
    static constexpr bool PERM = false, AFTER_DRAIN = true;
    const float* base; float* out; int ldc; const float* bias; PanelStats st; unsigned poison;
    __device__ __forceinline__ void fused(f32x4 (&acc)[2][2][4][2], const Unit& u, int wr, int wc, int fr, int fq, PG8_LAS unsigned char* lds, int wid, int lane) const {
        typedef float f32x2v __attribute__((ext_vector_type(2)));
        const PG8_LAS f32x2v* S = (const PG8_LAS f32x2v*)(lds + 8192);
        const int col0 = u.pn * BM + wc * 32 + 4 * fq;
#pragma unroll
        for (int bj = 0; bj < 2; ++bj)
#pragma unroll
            for (int n = 0; n < 2; ++n) { const f32x4 bv = bias ? *(const f32x4*)(bias + col0 + bj * HALF + n * 16) : (f32x4){0.f, 0.f, 0.f, 0.f};
#pragma unroll
                for (int ai = 0; ai < 2; ++ai)
#pragma unroll
                    for (int m = 0; m < 4; ++m) acc[ai][bj][m][n] += bv; }
        f32x4 pre[4][2][2];
#pragma unroll
        for (int m = 0; m < 4; ++m) { const size_t off = (size_t)(u.pm * BM + wr * 64 + m * 16 + fr) * ldc + col0;
#pragma unroll
            for (int bj = 0; bj < 2; ++bj)
#pragma unroll
                for (int n = 0; n < 2; ++n) pre[m][bj][n] = *(const f32x4*)(base + off + bj * HALF + n * 16); }
        const bool bad = st.run(acc, u, wr, wc, fr, fq, lds, wid, lane) || poison != 0u;
        const float qnan = __builtin_nanf("");
#pragma unroll
        for (int ai = 0; ai < 2; ++ai)
#pragma unroll
            for (int m = 0; m < 4; ++m) { const int r = ai * HALF + wr * 64 + m * 16 + fr; const f32x2v sr = S[r]; const size_t off = (size_t)(u.pm * BM + r) * ldc + col0;
#pragma unroll
                for (int bj = 0; bj < 2; ++bj)
#pragma unroll
                    for (int n = 0; n < 2; ++n) { const f32x4 bs = ai == 0 ? pre[m][bj][n] : *(const f32x4*)(base + off + bj * HALF + n * 16); f32x4 o = bs + (acc[ai][bj][m][n] - sr.x) * sr.y;
                        if (bad) o = (f32x4){qnan, qnan, qnan, qnan}; *(f32x4*)(out + off + bj * HALF + n * 16) = o; }
                if (m & 1) asm volatile("" ::: "memory"); }
    }
};
struct EpiLnResLn {
    static constexpr bool PERM = false, AFTER_DRAIN = true;
    const float* base; float* out; bf16_t* xn; int ldc; const float* bias; PanelStats st1, st2; unsigned poison;
    __device__ __forceinline__ void fused(f32x4 (&acc)[2][2][4][2], const Unit& u, int wr, int wc, int fr, int fq, PG8_LAS unsigned char* lds, int wid, int lane) const {
        typedef float f32x2v __attribute__((ext_vector_type(2))); typedef unsigned u32x2v __attribute__((ext_vector_type(2)));
        const PG8_LAS f32x2v* S = (const PG8_LAS f32x2v*)(lds + 8192);
        const int col0 = u.pn * BM + wc * 32 + 4 * fq;
#pragma unroll
        for (int bj = 0; bj < 2; ++bj)
#pragma unroll
            for (int n = 0; n < 2; ++n) { const f32x4 bv = bias ? *(const f32x4*)(bias + col0 + bj * HALF + n * 16) : (f32x4){0.f, 0.f, 0.f, 0.f};
#pragma unroll
                for (int ai = 0; ai < 2; ++ai)
#pragma unroll
                    for (int m = 0; m < 4; ++m) acc[ai][bj][m][n] += bv; }
        bool bad = st1.run(acc, u, wr, wc, fr, fq, lds, wid, lane) || poison != 0u;
        const float qnan = __builtin_nanf("");
#pragma unroll
        for (int ai = 0; ai < 2; ++ai)
#pragma unroll
            for (int m = 0; m < 4; ++m) { const int r = ai * HALF + wr * 64 + m * 16 + fr; const f32x2v sr = S[r]; const size_t off = (size_t)(u.pm * BM + r) * ldc + col0;
#pragma unroll
                for (int bj = 0; bj < 2; ++bj)
#pragma unroll
                    for (int n = 0; n < 2; ++n) { const f32x4 bs = *(const f32x4*)(base + off + bj * HALF + n * 16); acc[ai][bj][m][n] = bs + (acc[ai][bj][m][n] - sr.x) * sr.y; }
                asm volatile("" : "+v"(acc[ai][0][m][0]), "+v"(acc[ai][0][m][1]), "+v"(acc[ai][1][m][0]), "+v"(acc[ai][1][m][1]));
                if (m & 1) asm volatile("" ::: "memory"); }
        const bool bad1 = bad;
        bad = st2.run(acc, u, wr, wc, fr, fq, lds, wid, lane) || bad;
#pragma unroll
        for (int ai = 0; ai < 2; ++ai)
#pragma unroll
            for (int m = 0; m < 4; ++m) { const int r = ai * HALF + wr * 64 + m * 16 + fr; const f32x2v sr = S[r]; const size_t off = (size_t)(u.pm * BM + r) * ldc + col0;
#pragma unroll
                for (int bj = 0; bj < 2; ++bj)
#pragma unroll
                    for (int n = 0; n < 2; ++n) { const f32x4 x1 = acc[ai][bj][m][n]; *(f32x4*)(out + off + bj * HALF + n * 16) = bad1 ? (f32x4){qnan, qnan, qnan, qnan} : x1;
                        const f32x4 o = (x1 - sr.x) * sr.y; u32x2v w; w.x = cvt_pk_bf16(o[0], o[1]); w.y = cvt_pk_bf16(o[2], o[3]);
                        if (bad) { w.x = 0x7fc07fc0u; w.y = 0x7fc07fc0u; } *(u32x2v*)(xn + off + bj * HALF + n * 16) = w; }
                asm volatile("" ::: "memory"); }
    }
};

template <class Epi, class Sched, bool ALIGN_EPI = false, bool SP2 = false>
__device__ __forceinline__ void gemm_phase(PG8_LAS unsigned char* lds, const Gemm g, const Sched& S, const Epi& E) {
    int tid_ = threadIdx.x; asm volatile("" : "+v"(tid_));
    const int tid = tid_, wid = __builtin_amdgcn_readfirstlane(tid >> 6), lane = tid & 63, wr = wid >> 2, wc = wid & 3, fr = lane & 15, fq = lane >> 4;
    const int K = g.K, nt = K / BK;
    unsigned voffA[2], voffB[2];
#pragma unroll
    for (int i = 0; i < 2; ++i) { int R, C; stage_rc(tid * 16 + i * 8192, R, C); const int Rb = Epi::PERM ? ((R & ~31) + perm32(R & 31)) : R;
        voffA[i] = (unsigned)(R * K + C) * 2u; voffB[i] = (unsigned)(Rb * K + C) * 2u; }
    const size_t kstep = (size_t)(BK * 2);
    const size_t hstep = (size_t)HALF * K * 2;
    const size_t tstep = 2 * hstep;
    const unsigned ldsw = (unsigned)wid * 1024u;
    const int aoff = lds_byte(wr * 64 + fr, fq * 8), boff = lds_byte(wc * 32 + fr, fq * 8);
#define PG8_SA(b, h) (((b) * 2 + (h)) * HTB)
#define PG8_SB(b, h) ((4 + (b) * 2 + (h)) * HTB)
#define PG8_STAGE(bufoff, gbase, voff) do { _Pragma("unroll") for (int _i = 0; _i < 2; ++_i) \
        __builtin_amdgcn_global_load_lds((const unsigned*)((const char*)(gbase) + (voff)[_i]), (PG8_LAS unsigned*)(lds + (bufoff) + ldsw + _i * 8192), 16, 0, 0); } while (0)
#define PG8_LDA(dst, b, h) do { _Pragma("unroll") for (int m = 0; m < 4; ++m) _Pragma("unroll") for (int k = 0; k < 2; ++k) dst[m][k] = *(const PG8_LAS bf16x8*)(lds + PG8_SA(b, h) + aoff + m * 2048 + k * 1024); } while (0)
#define PG8_LDB(dst, b, h) do { _Pragma("unroll") for (int n = 0; n < 2; ++n) _Pragma("unroll") for (int k = 0; k < 2; ++k) dst[n][k] = *(const PG8_LAS bf16x8*)(lds + PG8_SB(b, h) + boff + n * 2048 + k * 1024); } while (0)
#define PG8_MMA(ai, bj, At, Bt) do { __builtin_amdgcn_s_setprio(1); _Pragma("unroll") for (int m = 0; m < 4; ++m) _Pragma("unroll") for (int n = 0; n < 2; ++n) _Pragma("unroll") for (int k = 0; k < 2; ++k) \
        acc[ai][bj][m][n] = __builtin_amdgcn_mfma_f32_16x16x32_bf16(Bt[n][k], At[m][k], acc[ai][bj][m][n], 0, 0, 0); __builtin_amdgcn_s_setprio(0); } while (0)
#define PG8_WAIT_V(n) asm volatile("s_waitcnt vmcnt(" #n ")" ::: "memory")
#define PG8_WAIT_L(n) asm volatile("s_waitcnt lgkmcnt(" #n ")" ::: "memory")
#define PG8_BAR __builtin_amdgcn_s_barrier()
#define PG8_SCHED __builtin_amdgcn_sched_barrier(0)
    Unit cur, nxt; int ui = 0;
    if (!S.next(0, cur)) return;
    f32x4 acc[2][2][4][2];
#pragma unroll
    for (int a = 0; a < 2; ++a)
#pragma unroll
        for (int b = 0; b < 2; ++b)
#pragma unroll
            for (int m = 0; m < 4; ++m)
#pragma unroll
                for (int n = 0; n < 2; ++n) acc[a][b][m][n] = (f32x4){0.f, 0.f, 0.f, 0.f};
    bf16x8 At[4][2], B0[2][2], B1[2][2];
    const char* cA = (const char*)g.A + (size_t)cur.pm * tstep; const char* cB = (const char*)g.Bt + (size_t)cur.pn * tstep;
    S.a_ready(cur);
    if constexpr (SP2) {
        PG8_STAGE(PG8_SB(0, 0), cB, voffB); PG8_STAGE(PG8_SB(0, 1), cB + hstep, voffB); PG8_STAGE(PG8_SA(0, 0), cA, voffA); PG8_STAGE(PG8_SA(0, 1), cA + hstep, voffA);
        if (wr == 1) PG8_BAR;
        PG8_WAIT_V(2); PG8_BAR;
        PG8_STAGE(PG8_SB(1, 0), cB + kstep, voffB); PG8_STAGE(PG8_SA(1, 0), cA + kstep, voffA); PG8_STAGE(PG8_SB(1, 1), cB + hstep + kstep, voffB);
        PG8_WAIT_V(6); PG8_BAR;
    } else {
        PG8_STAGE(PG8_SB(0, 0), cB, voffB); PG8_STAGE(PG8_SA(0, 0), cA, voffA); PG8_STAGE(PG8_SB(0, 1), cB + hstep, voffB); PG8_STAGE(PG8_SA(0, 1), cA + hstep, voffA);
        if (wr == 1) PG8_BAR;
        PG8_WAIT_V(4); PG8_BAR;
        PG8_STAGE(PG8_SB(1, 0), cB + kstep, voffB); PG8_STAGE(PG8_SA(1, 0), cA + kstep, voffA); PG8_STAGE(PG8_SB(1, 1), cB + hstep + kstep, voffB);
        PG8_WAIT_V(6); PG8_BAR;
    }
    for (;;) {
        const bool has_next = S.next(ui + 1, nxt);
        const char* nA = has_next ? (const char*)g.A + (size_t)nxt.pm * tstep : cA; const char* nB = has_next ? (const char*)g.Bt + (size_t)nxt.pn * tstep : cB;
        for (int t = 0; t < nt; t += 2) {
            const bool last = (t == nt - 2);
            const char* a1 = cA + (size_t)(t + 1) * kstep;
            const char* a2 = last ? nA : cA + (size_t)(t + 2) * kstep; const char* b2 = last ? nB : cB + (size_t)(t + 2) * kstep;
            const char* a3 = a2 + kstep; const char* b3 = b2 + kstep;
            if (last && has_next) S.a_ready(nxt);
            if constexpr (SP2) {
            PG8_LDB(B0, 0, 0); PG8_LDB(B1, 0, 1); PG8_SCHED; PG8_LDA(At, 0, 0); PG8_STAGE(PG8_SA(1, 1), a1 + hstep, voffA);
            PG8_WAIT_V(8); PG8_WAIT_L(0); PG8_BAR; PG8_MMA(0, 0, At, B0); PG8_MMA(0, 1, At, B1); PG8_BAR; PG8_SCHED;
            PG8_LDA(At, 0, 1); PG8_STAGE(PG8_SB(0, 0), b2, voffB); PG8_STAGE(PG8_SB(0, 1), b2 + hstep, voffB); PG8_STAGE(PG8_SA(0, 0), a2, voffA);
            PG8_WAIT_V(8); PG8_WAIT_L(0); PG8_BAR; PG8_MMA(1, 0, At, B0); PG8_MMA(1, 1, At, B1); PG8_BAR; PG8_SCHED;
            PG8_LDB(B0, 1, 0); PG8_LDB(B1, 1, 1); PG8_SCHED; PG8_LDA(At, 1, 0); PG8_STAGE(PG8_SA(0, 1), a2 + hstep, voffA);
            PG8_WAIT_V(8); PG8_WAIT_L(0); PG8_BAR; PG8_MMA(0, 0, At, B0); PG8_MMA(0, 1, At, B1); PG8_BAR; PG8_SCHED;
            PG8_LDA(At, 1, 1); PG8_STAGE(PG8_SB(1, 0), b3, voffB); PG8_STAGE(PG8_SB(1, 1), b3 + hstep, voffB); PG8_STAGE(PG8_SA(1, 0), a3, voffA);
            PG8_WAIT_V(8); PG8_WAIT_L(0); PG8_BAR; PG8_MMA(1, 0, At, B0); PG8_MMA(1, 1, At, B1); PG8_BAR; PG8_SCHED;
            } else {
            PG8_LDB(B0, 0, 0); PG8_SCHED; PG8_LDA(At, 0, 0); PG8_STAGE(PG8_SA(1, 1), a1 + hstep, voffA);
            PG8_WAIT_L(8); PG8_BAR; PG8_WAIT_L(0); PG8_MMA(0, 0, At, B0); PG8_BAR; PG8_SCHED;
            PG8_LDB(B1, 0, 1); PG8_STAGE(PG8_SB(0, 0), b2, voffB);
            PG8_BAR; PG8_WAIT_L(0); PG8_MMA(0, 1, At, B1); PG8_BAR;
            PG8_LDA(At, 0, 1); PG8_STAGE(PG8_SA(0, 0), a2, voffA);
            PG8_BAR; PG8_WAIT_L(0); PG8_MMA(1, 0, At, B0); PG8_BAR; PG8_SCHED;
            PG8_STAGE(PG8_SB(0, 1), b2 + hstep, voffB);
            PG8_WAIT_V(6); PG8_BAR; PG8_MMA(1, 1, At, B1); PG8_BAR;
            PG8_LDB(B0, 1, 0); PG8_SCHED; PG8_LDA(At, 1, 0); PG8_STAGE(PG8_SA(0, 1), a2 + hstep, voffA);
            PG8_WAIT_L(8); PG8_BAR; PG8_WAIT_L(0); PG8_MMA(0, 0, At, B0); PG8_BAR; PG8_SCHED;
            PG8_LDB(B1, 1, 1); PG8_STAGE(PG8_SB(1, 0), b3, voffB);
            PG8_BAR; PG8_WAIT_L(0); PG8_MMA(0, 1, At, B1); PG8_BAR;
            PG8_LDA(At, 1, 1); PG8_STAGE(PG8_SA(1, 0), a3, voffA);
            PG8_BAR; PG8_WAIT_L(0); PG8_MMA(1, 0, At, B0); PG8_BAR; PG8_SCHED;
            PG8_STAGE(PG8_SB(1, 1), b3 + hstep, voffB);
            PG8_WAIT_V(6); PG8_BAR; PG8_MMA(1, 1, At, B1); PG8_BAR;
            }
        }
        if constexpr (ALIGN_EPI) { if (wr == 0) PG8_BAR; }
        if constexpr (!Epi::AFTER_DRAIN) { E(acc, cur, wr, wc, fr, fq); S.done(cur); }
        if (!has_next) break;
#pragma unroll
        for (int a = 0; a < 2; ++a)
#pragma unroll
            for (int b = 0; b < 2; ++b)
#pragma unroll
                for (int m = 0; m < 4; ++m)
#pragma unroll
                    for (int n = 0; n < 2; ++n) acc[a][b][m][n] = (f32x4){0.f, 0.f, 0.f, 0.f};
        cur = nxt; cA = nA; cB = nB; ++ui;
        if constexpr (ALIGN_EPI) { if (wr == 1) PG8_BAR; }
    }
    PG8_WAIT_V(0);
    if constexpr (!ALIGN_EPI) { if (wr == 0) PG8_BAR; }
    PG8_BAR;
    if constexpr (Epi::AFTER_DRAIN) { E.fused(acc, cur, wr, wc, fr, fq, lds, wid, lane); S.done(cur); }
#undef PG8_SA
#undef PG8_SB
#undef PG8_STAGE
#undef PG8_LDA
#undef PG8_LDB
#undef PG8_MMA
#undef PG8_WAIT_V
#undef PG8_WAIT_L
#undef PG8_BAR
#undef PG8_SCHED
}
}

namespace pg8 {
struct EpiRes {
    static constexpr bool PERM = true, AFTER_DRAIN = false;
    const bf16_t* X; bf16_t* O; int ldc; float alpha;
    __device__ __forceinline__ void operator()(const f32x4 (&acc)[2][2][4][2], const Unit& u, int wr, int wc, int fr, int fq) const {
        const int row0 = u.pm * BM + wr * 64 + fr, col0 = u.pn * BM + wc * 32 + 8 * fq;
#pragma unroll
        for (int ai = 0; ai < 2; ++ai)
#pragma unroll
            for (int m = 0; m < 4; ++m) { const size_t off = (size_t)(row0 + ai * HALF + m * 16) * ldc + col0;
#pragma unroll
                for (int bj = 0; bj < 2; ++bj) { const u32x4 xv = *(const u32x4*)(X + off + bj * HALF);
                    f32x4 x0, x1;
                    x0[0] = __uint_as_float(xv.x << 16); x0[1] = __uint_as_float(xv.x & 0xffff0000u); x0[2] = __uint_as_float(xv.y << 16); x0[3] = __uint_as_float(xv.y & 0xffff0000u);
                    x1[0] = __uint_as_float(xv.z << 16); x1[1] = __uint_as_float(xv.z & 0xffff0000u); x1[2] = __uint_as_float(xv.w << 16); x1[3] = __uint_as_float(xv.w & 0xffff0000u);
                    const f32x4 v0 = x0 * alpha + acc[ai][bj][m][0], v1 = x1 * alpha + acc[ai][bj][m][1];
                    u32x4 w; w.x = cvt_pk_bf16(v0[0], v0[1]); w.y = cvt_pk_bf16(v0[2], v0[3]); w.z = cvt_pk_bf16(v1[0], v1[1]); w.w = cvt_pk_bf16(v1[2], v1[3]);
                    *(u32x4*)(O + off + bj * HALF) = w; } }
    }
};
}

#define LAS __attribute__((address_space(3)))
typedef unsigned short bf16;
typedef short bf16x8 __attribute__((ext_vector_type(8)));
typedef short s16x4 __attribute__((ext_vector_type(4)));
typedef float f32x4 __attribute__((ext_vector_type(4)));
typedef float f32x16 __attribute__((ext_vector_type(16)));
typedef unsigned u32x4 __attribute__((ext_vector_type(4)));
typedef unsigned u32x2 __attribute__((ext_vector_type(2)));

constexpr int DM = 1024, MP = 65536, MS = 16384, MTOK = MP + MS, SP = 4096, SS = 16384, DFF = 4096;
constexpr int NPROJ = 1792;
constexpr int INW = 1280;
constexpr float LN_EPS = 1e-5f;
constexpr float ALPHA = 1.4142135623730951f;
constexpr float LOG2E = 1.4426950408889634f;
constexpr int NWAVES = 8, NTHR = 512;
constexpr int LDS_BYTES = 147456;

constexpr size_t MiB = 1u << 20;
constexpr size_t WS_TAB = 1 * MiB;
constexpr size_t T_A1P = 0, T_A1S = 32768, T_A2P = 163840, T_A2S = 180224, T_TWP = 245760, T_TWS = 278528;
constexpr size_t WS_W = 2 * MiB, W_LAYER = 22 * MiB, W_IN = 0, W_OUT = 4 * MiB, W_FF1 = 6 * MiB, W_FF2 = 14 * MiB;
constexpr size_t WS_X = 48 * MiB, WS_Z = 208 * MiB, WS_H = 368 * MiB, WS_PROJ = 368 * MiB, WS_END = 1008 * MiB;

__device__ __forceinline__ unsigned f2bf(float f) { unsigned u = __builtin_bit_cast(unsigned, f); return (u + 0x7fffu + ((u >> 16) & 1u)) >> 16; }
__device__ __forceinline__ unsigned pk2(float lo, float hi) { return f2bf(lo) | (f2bf(hi) << 16); }
__device__ __forceinline__ float bflo(unsigned u) { return __uint_as_float(u << 16); }
__device__ __forceinline__ float bfhi(unsigned u) { return __uint_as_float(u & 0xffff0000u); }
__device__ __forceinline__ float wave_sum(float v) {
#pragma unroll
    for (int o = 1; o < 64; o <<= 1) v += __shfl_xor(v, o);
    return v;
}
__device__ __forceinline__ s16x4 vtr(const LAS unsigned char* p) { return __builtin_bit_cast(s16x4, __builtin_amdgcn_ds_read_tr16_b64_v4i16((LAS s16x4*)p)); }
__device__ __forceinline__ bf16x8 cat8(s16x4 lo, s16x4 hi) { return (bf16x8){lo[0], lo[1], lo[2], lo[3], hi[0], hi[1], hi[2], hi[3]}; }
#define LDS_WAIT() asm volatile("s_waitcnt lgkmcnt(0)" ::: "memory")

__device__ __forceinline__ void p0_transpose_item(const float* W, int ldw, int col_off, int ncols, int K, bf16* WT, int row_off, LAS float* scr, int item, int lane) {
    const int nblk = ncols / 32, kb = item / nblk, nb = item % nblk, k0 = 64 * kb, n0 = 32 * nb;
#pragma unroll 8
    for (int i = 0; i < 32; ++i) { const int kk = 2 * i + (lane >> 5); scr[kk * 33 + (lane & 31)] = W[(size_t)(k0 + kk) * ldw + col_off + n0 + (lane & 31)]; }
    LDS_WAIT(); asm volatile("" ::: "memory");
    const int c = lane & 7;
#pragma unroll
    for (int j = 0; j < 4; ++j) { const int n = (lane >> 3) + 8 * j; const LAS float* s = scr + (8 * c) * 33 + n;
        u32x4 o; o.x = pk2(s[0 * 33], s[1 * 33]); o.y = pk2(s[2 * 33], s[3 * 33]); o.z = pk2(s[4 * 33], s[5 * 33]); o.w = pk2(s[6 * 33], s[7 * 33]);
        *(u32x4*)(WT + (size_t)(row_off + n0 + n) * K + k0 + 8 * c) = o; }
    LDS_WAIT(); asm volatile("" ::: "memory");
}
__device__ __forceinline__ void ln_emb_row(const float* xrow, const float* g, const float* b, bf16* orow, int lane) {
    const f32x4* xr = (const f32x4*)xrow + lane;
    f32x4 v[4]; float s = 0.f;
#pragma unroll
    for (int j = 0; j < 4; ++j) { v[j] = xr[64 * j]; s += (v[j].x + v[j].y) + (v[j].z + v[j].w); }
    const float mean = wave_sum(s) * (1.f / DM); float s2 = 0.f;
#pragma unroll
    for (int j = 0; j < 4; ++j) { v[j] = v[j] - mean; s2 += (v[j].x * v[j].x + v[j].y * v[j].y) + (v[j].z * v[j].z + v[j].w * v[j].w); }
    const float rstd = 1.f / sqrtf(wave_sum(s2) * (1.f / DM) + LN_EPS);
    u32x2* o8 = (u32x2*)orow + lane;
#pragma unroll
    for (int j = 0; j < 4; ++j) { const f32x4 gg = ((const f32x4*)g)[lane + 64 * j], bb = ((const f32x4*)b)[lane + 64 * j]; const f32x4 y = v[j] * rstd * gg + bb;
        u32x2 w; w.x = pk2(y.x, y.y); w.y = pk2(y.z, y.w); o8[64 * j] = w; }
}
__device__ __forceinline__ void fold_task(LAS unsigned char* lds, const float* w_in_l, const float* wf_l, bf16* wt_in_l, int task, int tid) {
    LAS float* tab = (LAS float*)lds;
    LAS float* Mt = (LAS float*)(lds + 1024);
    LAS float* At = (LAS float*)(lds + 1024 + 32768);
    const int kt = task >> 4, cb = task & 15, g = cb >> 2, ri = (cb >> 1) & 1, eh = cb & 1;
    if (tid < 128) tab[tid] = cospif((float)tid * (1.0f / 64.0f));
    for (int i = tid; i < 64 * 128; i += NTHR) { const int kk = i >> 7, c = i & 127; At[kk * 129 + c] = w_in_l[(size_t)(64 * kt + kk) * INW + g * 128 + c]; }
    __syncthreads();
    {
        const int e = eh * 64 + (tid & 63), c0 = (tid >> 6) * 16; const int off = ri ? 32 : 0;
        float acc[16];
#pragma unroll
        for (int j = 0; j < 16; ++j) acc[j] = 0.f;
        const float* wf = wf_l + (size_t)g * 128 * 128 + e;
        for (int d = 0; d < 128; ++d) { const float w = wf[d * 128];
#pragma unroll
            for (int j = 0; j < 16; ++j) acc[j] += tab[((c0 + j) * d + off) & 127] * w; }
#pragma unroll
        for (int j = 0; j < 16; ++j) Mt[(c0 + j) * 64 + (tid & 63)] = acc[j] * 0.08838834764831845f;
    }
    __syncthreads();
    {
        const int kk = tid & 63, e0 = (tid >> 6) * 8; float acc[8];
#pragma unroll
        for (int j = 0; j < 8; ++j) acc[j] = 0.f;
        for (int c = 0; c < 128; ++c) { const float a = At[kk * 129 + c]; const f32x4 m0 = *(const LAS f32x4*)(Mt + c * 64 + e0), m1 = *(const LAS f32x4*)(Mt + c * 64 + e0 + 4);
            acc[0] += a * m0.x; acc[1] += a * m0.y; acc[2] += a * m0.z; acc[3] += a * m0.w; acc[4] += a * m1.x; acc[5] += a * m1.y; acc[6] += a * m1.z; acc[7] += a * m1.w; }
#pragma unroll
        for (int j = 0; j < 8; ++j) wt_in_l[(size_t)(ri * 512 + g * 128 + eh * 64 + e0 + j) * DM + 64 * kt + kk] = (bf16)f2bf(acc[j]);
    }
    __syncthreads();
}
__device__ __forceinline__ void make_tables(unsigned char* tabs, int gtid, int gthreads) {
    bf16* A1P = (bf16*)(tabs + T_A1P); bf16* A1S = (bf16*)(tabs + T_A1S); bf16* A2P = (bf16*)(tabs + T_A2P); bf16* A2S = (bf16*)(tabs + T_A2S);
    float2* TWP = (float2*)(tabs + T_TWP); float2* TWS = (float2*)(tabs + T_TWS);
    for (int i = gtid; i < 128 * 128; i += gthreads) {
        const int m = i >> 7, k = i & 127, k1 = m & 63, s1 = k & 63; const float x = (float)((k1 * s1) & 63) * (1.0f / 32.0f);
        const float c = cospif(x) * 0.125f, s = sinpif(x) * 0.125f; const int im = m >> 6, vi = k >> 6;
        A1P[i] = (bf16)f2bf(im == 0 ? (vi == 0 ? c : s) : (vi == 0 ? -s : c)); }
    for (int i = gtid; i < 256 * 256; i += gthreads) {
        const int m = i >> 8, k = i & 255, k1 = m & 127, s1 = k & 127; const float x = (float)((k1 * s1) & 127) * (1.0f / 64.0f);
        const float sc = 0.08838834764831845f; const float c = cospif(x) * sc, s = sinpif(x) * sc; const int im = m >> 7, vi = k >> 7;
        A1S[i] = (bf16)f2bf(im == 0 ? (vi == 0 ? c : s) : (vi == 0 ? -s : c)); }
    for (int i = gtid; i < 64 * 128; i += gthreads) {
        const int k2 = i >> 7, k = i & 127, s2 = k & 63; const float x = (float)((k2 * s2) & 63) * (1.0f / 32.0f);
        A2P[i] = (bf16)f2bf((k >> 6) == 0 ? cospif(x) * 0.125f : sinpif(x) * 0.125f); }
    for (int i = gtid; i < 128 * 256; i += gthreads) {
        const int k2 = i >> 8, k = i & 255, s2 = k & 127; const float x = (float)((k2 * s2) & 127) * (1.0f / 64.0f); const float sc = 0.08838834764831845f;
        A2S[i] = (bf16)f2bf((k >> 7) == 0 ? cospif(x) * sc : sinpif(x) * sc); }
    for (int i = gtid; i < 64 * 64; i += gthreads) {
        const int s2 = i >> 6, k1 = i & 63; const float x = (float)(s2 * k1) * (1.0f / 2048.0f); TWP[i] = make_float2(cospif(x), -sinpif(x)); }
    for (int i = gtid; i < 128 * 128; i += gthreads) {
        const int s2 = i >> 7, k1 = i & 127; const float x = (float)(s2 * k1) * (1.0f / 8192.0f); TWS[i] = make_float2(cospif(x), -sinpif(x)); }
}

template <int N1>
__device__ __forceinline__ void fft1_task(LAS unsigned char* lds, const bf16* PROJ, bf16* ZP, const bf16* A1, const float2* TW, size_t row_base, int s2, int g, int tid) {
    constexpr int K2 = 2 * N1, RS = 320;
    for (int c = tid; c < K2 * 16; c += NTHR) { const int r = c >> 4, ch = c & 15, s1 = r & (N1 - 1), im = r / N1;
        const u32x4 v = *(const u32x4*)(PROJ + (row_base + (size_t)s1 * N1 + s2) * NPROJ + im * 512 + g * 128 + ch * 8);
        *(LAS u32x4*)(lds + r * RS + ch * 16) = v; }
    __syncthreads();
    const int lane = tid & 63, w = tid >> 6, h = lane >> 5, c32 = lane & 31, i16 = lane & 15;
    const int troff = (8 * h + (i16 >> 2)) * RS + (16 * ((lane >> 4) & 1) + 4 * (i16 & 3)) * 2;
    constexpr int NPAIR = (N1 / 32) * 4;
    for (int pi = w; pi < NPAIR; pi += NWAVES) {
        const int nt = pi & 3, mi = pi >> 2;
        f32x16 are, aim;
#pragma unroll
        for (int r = 0; r < 16; ++r) { are[r] = 0.f; aim[r] = 0.f; }
        const bf16* arp = A1 + (size_t)(32 * mi + c32) * K2 + 8 * h;
        const bf16* aip = arp + (size_t)N1 * K2;
        const LAS unsigned char* tb = lds + troff + nt * 64;
#pragma unroll 4
        for (int ks = 0; ks < K2 / 16; ++ks) {
            const s16x4 lo = vtr(tb + ks * 16 * RS), hi = vtr(tb + ks * 16 * RS + 4 * RS);
            const bf16x8 bfr = cat8(lo, hi);
            const bf16x8 ar = *(const bf16x8*)(arp + ks * 16), ai = *(const bf16x8*)(aip + ks * 16);
            are = __builtin_amdgcn_mfma_f32_32x32x16_bf16(ar, bfr, are, 0, 0, 0);
            aim = __builtin_amdgcn_mfma_f32_32x32x16_bf16(ai, bfr, aim, 0, 0, 0);
        }
#pragma unroll
        for (int r = 0; r < 16; ++r) { const int k1 = 32 * mi + (r & 3) + 8 * (r >> 2) + 4 * h; const float2 t = TW[s2 * N1 + k1];
            const float zr = are[r] * t.x - aim[r] * t.y, zi = are[r] * t.y + aim[r] * t.x;
            bf16* o = ZP + (row_base + (size_t)k1 * N1 + s2) * DM + g * 128 + nt * 32 + c32;
            o[0] = (bf16)f2bf(zr); o[512] = (bf16)f2bf(zi); }
    }
    __syncthreads();
}
template <int N2>
__device__ __forceinline__ void fft2_task(LAS unsigned char* lds, const bf16* ZP, bf16* HEADS, const bf16* A2, size_t row_base, int k1, int g, int tid) {
    constexpr int K2 = 2 * N2, RS = 320;
    for (int c = tid; c < K2 * 16; c += NTHR) { const int r = c >> 4, ch = c & 15, s2 = r & (N2 - 1), im = r / N2;
        const u32x4 v = *(const u32x4*)(ZP + (row_base + (size_t)k1 * N2 + s2) * DM + im * 512 + g * 128 + ch * 8);
        *(LAS u32x4*)(lds + r * RS + ch * 16) = v; }
    __syncthreads();
    const int lane = tid & 63, w = tid >> 6, h = lane >> 5, c32 = lane & 31, i16 = lane & 15;
    const int troff = (8 * h + (i16 >> 2)) * RS + (16 * ((lane >> 4) & 1) + 4 * (i16 & 3)) * 2;
    constexpr int NTILE = (N2 / 32) * 4;
    for (int ti = w; ti < NTILE; ti += NWAVES) {
        const int nt = ti & 3, mi = ti >> 2;
        f32x16 acc;
#pragma unroll
        for (int r = 0; r < 16; ++r) acc[r] = 0.f;
        const bf16* ap = A2 + (size_t)(32 * mi + c32) * K2 + 8 * h;
        const LAS unsigned char* tb = lds + troff + nt * 64;
#pragma unroll 4
        for (int ks = 0; ks < K2 / 16; ++ks) {
            const s16x4 lo = vtr(tb + ks * 16 * RS), hi = vtr(tb + ks * 16 * RS + 4 * RS);
            const bf16x8 bfr = cat8(lo, hi);
            const bf16x8 a = *(const bf16x8*)(ap + ks * 16);
            acc = __builtin_amdgcn_mfma_f32_32x32x16_bf16(a, bfr, acc, 0, 0, 0);
        }
#pragma unroll
        for (int r = 0; r < 16; ++r) { const int k2 = 32 * mi + (r & 3) + 8 * (r >> 2) + 4 * h;
            HEADS[(row_base + (size_t)k1 + (size_t)N2 * k2) * DM + g * 128 + nt * 32 + c32] = (bf16)f2bf(acc[r]); }
    }
    __syncthreads();
}

__device__ __forceinline__ unsigned cvtpk(float lo, float hi) { typedef float f2 __attribute__((ext_vector_type(2))); typedef __bf16 b2 __attribute__((ext_vector_type(2))); f2 v = {lo, hi}; b2 b = __builtin_convertvector(v, b2); return __builtin_bit_cast(unsigned, b); }
__device__ __forceinline__ void attn_task(LAS unsigned char* lds, const bf16* PROJ, bf16* HEADS, const float* sink, size_t row_base, int S, int n, int kv, int tid) {
    constexpr int KRS = 144, VT = 384 * 64;
    LAS unsigned char* Kl = lds; LAS unsigned char* Vl = lds + 384 * KRS;
    const int nb = S / 128;
    for (int c = tid; c < 384 * 8; c += NTHR) { const int si = c >> 3, ch = c & 7, kp = n * 128 - 128 + si;
        u32x4 kk = {0u, 0u, 0u, 0u}, vv = {0u, 0u, 0u, 0u};
        if (kp >= 0 && kp < S) { const bf16* src = PROJ + (row_base + (size_t)kp) * NPROJ + 1536 + kv * 64 + ch * 8; kk = *(const u32x4*)src; vv = *(const u32x4*)(src + 128); }
        *(LAS u32x4*)(Kl + si * KRS + ch * 16) = kk;
        *(LAS u32x4*)(Vl + (ch >> 2) * VT + si * 64 + (ch & 3) * 16) = vv; }
    __syncthreads();
    const int lane = tid & 63, w = tid >> 6, h = lane >> 5, c32 = lane & 31, i16 = lane & 15;
    const int lo_valid = (n == 0) ? 128 : 0, hi_valid = (n == nb - 1) ? 256 : 384;
    const int vtoff = (4 * h + (i16 >> 2)) * 64 + (16 * ((lane >> 4) & 1) + 4 * (i16 & 3)) * 2;
    for (int qt = w; qt < 16; qt += NWAVES) {
        const int hh = qt >> 2, qo = 32 * (qt & 3), head = kv * 4 + hh, qi = qo + c32;
        const float slope2 = __builtin_amdgcn_exp2f(-(float)(head + 1)) * LOG2E;
        const size_t qrow = row_base + (size_t)n * 128 + qi;
        bf16x8 qf[4];
#pragma unroll
        for (int ds = 0; ds < 4; ++ds) qf[ds] = *(const bf16x8*)(PROJ + qrow * NPROJ + 1024 + head * 64 + 16 * ds + 8 * h);
        float m = sink[head] * LOG2E, l = (h == 0) ? 1.f : 0.f;
        f32x16 o0, o1;
#pragma unroll
        for (int r = 0; r < 16; ++r) { o0[r] = 0.f; o1[r] = 0.f; }
        for (int kt = 0; kt < 9; ++kt) {
            const int si0 = qo + 32 * kt;
            if (si0 + 31 < lo_valid || si0 >= hi_valid) continue;
            f32x16 s;
#pragma unroll
            for (int r = 0; r < 16; ++r) s[r] = 0.f;
#pragma unroll
            for (int ds = 0; ds < 4; ++ds) { const bf16x8 kf = *(const LAS bf16x8*)(Kl + (si0 + c32) * KRS + (16 * ds + 8 * h) * 2); s = __builtin_amdgcn_mfma_f32_32x32x16_bf16(kf, qf[ds], s, 0, 0, 0); }
            float mx = m;
#pragma unroll
            for (int r = 0; r < 16; ++r) { const int si = si0 + (r & 3) + 8 * (r >> 2) + 4 * h; const int rel = si - 128 - qi; const int d = rel < 0 ? -rel : rel;
                const bool ok = (d <= 128) && (si >= lo_valid) && (si < hi_valid);
                float t = s[r] * (0.125f * LOG2E) - slope2 * (float)d; t = ok ? t : -1e30f; s[r] = t; mx = fmaxf(mx, t); }
            mx = fmaxf(mx, __shfl_xor(mx, 32));
            const float alpha = __builtin_amdgcn_exp2f(m - mx); m = mx;
            float ps = 0.f;
#pragma unroll
            for (int r = 0; r < 16; ++r) { const float p = __builtin_amdgcn_exp2f(s[r] - mx); s[r] = p; ps += p; }
            l = l * alpha + ps;
#pragma unroll
            for (int r = 0; r < 16; ++r) { o0[r] *= alpha; o1[r] *= alpha; }
            u32x4 p0, p1;
            p0.x = cvtpk(s[0], s[1]); p0.y = cvtpk(s[2], s[3]); p0.z = cvtpk(s[4], s[5]); p0.w = cvtpk(s[6], s[7]);
            p1.x = cvtpk(s[8], s[9]); p1.y = cvtpk(s[10], s[11]); p1.z = cvtpk(s[12], s[13]); p1.w = cvtpk(s[14], s[15]);
            const bf16x8 pf0 = __builtin_bit_cast(bf16x8, p0), pf1 = __builtin_bit_cast(bf16x8, p1);
            const LAS unsigned char* vb = Vl + si0 * 64 + vtoff;
            {   const bf16x8 v00 = cat8(vtr(vb), vtr(vb + 8 * 64)), v01 = cat8(vtr(vb + 16 * 64), vtr(vb + 24 * 64));
                o0 = __builtin_amdgcn_mfma_f32_32x32x16_bf16(v00, pf0, o0, 0, 0, 0); o0 = __builtin_amdgcn_mfma_f32_32x32x16_bf16(v01, pf1, o0, 0, 0, 0); }
            {   const bf16x8 v10 = cat8(vtr(vb + VT), vtr(vb + VT + 8 * 64)), v11 = cat8(vtr(vb + VT + 16 * 64), vtr(vb + VT + 24 * 64));
                o1 = __builtin_amdgcn_mfma_f32_32x32x16_bf16(v10, pf0, o1, 0, 0, 0); o1 = __builtin_amdgcn_mfma_f32_32x32x16_bf16(v11, pf1, o1, 0, 0, 0); }
        }
        l += __shfl_xor(l, 32);
        const float inv = 1.0f / l;
        bf16* orow = HEADS + qrow * DM + 512 + head * 64 + 4 * h;
#pragma unroll
        for (int r4 = 0; r4 < 4; ++r4) {
            u32x2 a, b; a.x = cvtpk(o0[4 * r4] * inv, o0[4 * r4 + 1] * inv); a.y = cvtpk(o0[4 * r4 + 2] * inv, o0[4 * r4 + 3] * inv);
            b.x = cvtpk(o1[4 * r4] * inv, o1[4 * r4 + 1] * inv); b.y = cvtpk(o1[4 * r4 + 2] * inv, o1[4 * r4 + 3] * inv);
            *(u32x2*)(orow + 8 * r4) = a; *(u32x2*)(orow + 32 + 8 * r4) = b; }
    }
    __syncthreads();
}

__device__ __forceinline__ void ln_pass(const bf16* Z, const float* gam, const float* bet, bf16* Xo, float* Fo, int gw, int ngw, int lane) {
    f32x4 g0 = ((const f32x4*)gam)[2 * lane], g1 = ((const f32x4*)gam)[2 * lane + 1], g2 = ((const f32x4*)gam)[128 + 2 * lane], g3 = ((const f32x4*)gam)[128 + 2 * lane + 1];
    f32x4 b0 = ((const f32x4*)bet)[2 * lane], b1 = ((const f32x4*)bet)[2 * lane + 1], b2 = ((const f32x4*)bet)[128 + 2 * lane], b3 = ((const f32x4*)bet)[128 + 2 * lane + 1];
    for (int m = gw; m < MTOK; m += ngw) {
        const u32x4 a = *(const u32x4*)(Z + (size_t)m * DM + 8 * lane), c = *(const u32x4*)(Z + (size_t)m * DM + 512 + 8 * lane);
        f32x4 v0 = {bflo(a.x), bfhi(a.x), bflo(a.y), bfhi(a.y)}, v1 = {bflo(a.z), bfhi(a.z), bflo(a.w), bfhi(a.w)};
        f32x4 v2 = {bflo(c.x), bfhi(c.x), bflo(c.y), bfhi(c.y)}, v3 = {bflo(c.z), bfhi(c.z), bflo(c.w), bfhi(c.w)};
        f32x4 t = (v0 + v1) + (v2 + v3);
        const float mean = wave_sum((t.x + t.y) + (t.z + t.w)) * (1.f / DM);
        v0 = v0 - mean; v1 = v1 - mean; v2 = v2 - mean; v3 = v3 - mean;
        t = (v0 * v0 + v1 * v1) + (v2 * v2 + v3 * v3);
        const float rstd = 1.f / sqrtf(wave_sum((t.x + t.y) + (t.z + t.w)) * (1.f / DM) + LN_EPS);
        v0 = v0 * rstd * g0 + b0; v1 = v1 * rstd * g1 + b1; v2 = v2 * rstd * g2 + b2; v3 = v3 * rstd * g3 + b3;
        if (Fo) { f32x4* o = (f32x4*)(Fo + (size_t)m * DM + 8 * lane); o[0] = v0; o[1] = v1; o[128] = v2; o[129] = v3; }
        else { u32x4 w0, w1; w0.x = pk2(v0.x, v0.y); w0.y = pk2(v0.z, v0.w); w0.z = pk2(v1.x, v1.y); w0.w = pk2(v1.z, v1.w);
            w1.x = pk2(v2.x, v2.y); w1.y = pk2(v2.z, v2.w); w1.z = pk2(v3.x, v3.y); w1.w = pk2(v3.z, v3.w);
            *(u32x4*)(Xo + (size_t)m * DM + 8 * lane) = w0; *(u32x4*)(Xo + (size_t)m * DM + 512 + 8 * lane) = w1; }
    }
}

#define XB_TMO      128
#define XB_XCNT(j)  (256  + 64 * (j))
#define XB_XSUB(j)  (1280 + 64 * (j))
#define XB_XGEN(j)  (2304 + 64 * (j))
#define XB_TOP      3328
#define XB_TOPGEN   3392
#define XCD_BAR_WORDS 3456
#define XB_SPIN_CAP (1u << 18)

__device__ __forceinline__ unsigned xb_ld(unsigned* p)              { return __hip_atomic_load(p, __ATOMIC_RELAXED, __HIP_MEMORY_SCOPE_AGENT); }
__device__ __forceinline__ unsigned xb_add(unsigned* p, unsigned v) { return __hip_atomic_fetch_add(p, v, __ATOMIC_RELAXED, __HIP_MEMORY_SCOPE_AGENT); }
__device__ __forceinline__ unsigned xb_xcc_id() { return (unsigned)__builtin_amdgcn_s_getreg((3 << 11) | 20) & 0xFu; }
#define XB_SPIN(cond, bar) do { unsigned _sp = 0; while (cond) { __builtin_amdgcn_s_sleep(1); \
    if ((++_sp & 255u) == 0u) { if (xb_ld(&(bar)[XB_TMO])) break; if (_sp > XB_SPIN_CAP) { atomicAdd(&(bar)[XB_TMO], 1u); break; } } } } while (0)

struct XcdBarrier {
    unsigned* bar; unsigned x;
    volatile LAS unsigned* st;
};

__device__ __forceinline__ XcdBarrier xcd_barrier_post(unsigned* bar, volatile LAS unsigned* st) {
    XcdBarrier b; b.bar = bar; b.x = xb_xcc_id(); b.st = st;
    if (threadIdx.x == 0) (void)xb_add(&bar[XB_XCNT(b.x)], 1u);
    return b;
}
__device__ __forceinline__ void xcd_barrier_complete(unsigned* bar, unsigned x, unsigned& nloc, unsigned& nx) {
    const unsigned G = gridDim.x * gridDim.y * gridDim.z;
    unsigned sum, cnt, mine, sp = 0u;
    for (;;) {
        sum = 0u; cnt = 0u; mine = 0u;
#pragma unroll
        for (unsigned j = 0; j < 16; ++j) { const unsigned c = xb_ld(&bar[XB_XCNT(j)]); sum += c; cnt += (c > 0u) ? 1u : 0u; mine = (j == x) ? c : mine; }
        if (sum == G) break;
        __builtin_amdgcn_s_sleep(1);
        if ((++sp & 255u) == 0u) { if (xb_ld(&bar[XB_TMO])) break; if (sp > XB_SPIN_CAP) { atomicAdd(&bar[XB_TMO], 1u); break; } }
    }
    nloc = mine > 0u ? mine : 1u; nx = cnt > 0u ? cnt : 1u;
}

__device__ __forceinline__ void xcd_barrier(const XcdBarrier& b) {
    asm volatile("s_waitcnt vmcnt(0)" ::: "memory");
    __syncthreads();
    if (threadIdx.x == 0) {
        unsigned* bar = b.bar;
        __builtin_amdgcn_s_waitcnt(0);
        unsigned nloc = b.st[0], nx = b.st[1];
        if (nloc == 0u) { xcd_barrier_complete(bar, b.x, nloc, nx); b.st[0] = nloc; b.st[1] = nx; }
        const unsigned old = xb_add(&bar[XB_XSUB(b.x)], 1u);
        const unsigned gen = old / nloc;
        if (old + 1u == (gen + 1u) * nloc) {
            __builtin_amdgcn_fence(__ATOMIC_RELEASE, "agent");
            asm volatile("s_waitcnt vmcnt(0)" ::: "memory");
            const unsigned og = xb_add(&bar[XB_TOP], 1u);
            const unsigned tg = og / nx;
            if (og + 1u == (tg + 1u) * nx) xb_add(&bar[XB_TOPGEN], 1u);
            else XB_SPIN(xb_ld(&bar[XB_TOPGEN]) == tg, bar);
            __builtin_amdgcn_fence(__ATOMIC_ACQUIRE, "agent");
            xb_add(&bar[XB_XGEN(b.x)], 1u);
            asm volatile("s_waitcnt vmcnt(0)" ::: "memory");
        } else {
            XB_SPIN(xb_ld(&bar[XB_XGEN(b.x)]) == gen, bar);
            __builtin_amdgcn_fence(__ATOMIC_ACQUIRE, "agent");
            asm volatile("s_waitcnt vmcnt(0)" ::: "memory");
        }
    }
    __syncthreads();
}

struct Args { const float* in[14]; float* out; unsigned char* ws; int ph_lo, ph_hi; };
constexpr int NPHASE = 17;
#ifndef DUP_MIX
#define DUP_MIX 1
#endif
#ifndef DUP_ATT
#define DUP_ATT 0
#endif
#ifndef DUP_LN
#define DUP_LN 1
#endif
#ifndef DUP_P0
#define DUP_P0 1
#endif
typedef const __attribute__((address_space(4))) Args* ArgsP;
__device__ __forceinline__ ArgsP get_args() { ArgsP p = (ArgsP)__builtin_amdgcn_kernarg_segment_ptr(); asm volatile("" : "+s"(p)); return p; }
#define WSP(ap, off) ((ap)->ws + (off))
#define XBUF(ap) ((bf16*)WSP(ap, WS_X))
#define ZBUF(ap) ((bf16*)WSP(ap, WS_Z))
#define HBUF(ap) ((bf16*)WSP(ap, WS_H))
#define PROJBUF(ap) ((bf16*)WSP(ap, WS_PROJ))
#define ZPBUF(ap) ((bf16*)(ap)->out)
#define HEADSBUF(ap) ((bf16*)(ap)->out + (size_t)MTOK * DM)
#define TABS(ap) WSP(ap, WS_TAB)
#define WL(ap, L, off) ((const bf16*)WSP(ap, WS_W + (size_t)(L) * W_LAYER + (off)))
__global__ void __launch_bounds__(NTHR, 2) hymba_fwd(Args args_unused) {
    extern __shared__ __attribute__((aligned(16))) unsigned char lds_raw[];
    LAS unsigned char* lds = (LAS unsigned char*)lds_raw;
    cg::grid_group grid = cg::this_grid();
    const int G = gridDim.x, bx = blockIdx.x;
    {
        volatile LAS unsigned* MISC0 = (volatile LAS unsigned*)(lds + 131072 + 320);
        if (threadIdx.x < 32) MISC0[threadIdx.x] = 0u;
        if (bx == 0) { unsigned* bw = (unsigned*)get_args()->ws + 4096; for (int i = threadIdx.x; i < XCD_BAR_WORDS; i += NTHR) bw[i] = 0u; }
        __syncthreads();
    }
#define XBAR() do { XcdBarrier b_; b_.bar = (unsigned*)get_args()->ws + 4096; b_.x = xb_xcc_id(); b_.st = (volatile LAS unsigned*)(lds + 131072 + 320) + 8; xcd_barrier(b_); } while (0)
#define FRESH() int tid = threadIdx.x; asm volatile("" : "+v"(tid)); const int lane = tid & 63, wave = __builtin_amdgcn_readfirstlane(tid >> 6); (void)lane; (void)wave;
#define IN(k) (get_args()->ph_lo <= (k) && (k) < get_args()->ph_hi)
#ifndef DUP_SYNC
#define DUP_SYNC 1
#endif
#define SEAM(k) do { if (IN(k) && IN((k) + 1)) { for (int rs = 0; rs < DUP_SYNC; ++rs) XBAR(); } } while (0)

    for (int rep0 = 0; rep0 < DUP_P0; ++rep0) if (IN(0)) {
        if (rep0) __syncthreads();
        FRESH(); ArgsP ap = get_args();
        for (int t = bx; t < 512; t += G) { const int L = t >> 8;
            fold_task(lds, ap->in[4] + (size_t)L * DM * INW, ap->in[5] + (size_t)L * 4 * 128 * 128, (bf16*)WL(ap, L, W_IN), t & 255, tid); }
        LAS float* scr = (LAS float*)(lds + wave * 16384);
        const int gw = bx * NWAVES + wave, ngw = G * NWAVES;
        constexpr int I_QKV = 16 * 24, I_O = 16 * 32, I_1 = 16 * 128, I_2 = 64 * 32, I_L = I_QKV + I_O + I_1 + I_2;
        for (int it = gw; it < 2 * I_L; it += ngw) {
            const int L = it / I_L; int r = it % I_L;
            if (r < I_QKV) { p0_transpose_item(ap->in[4] + (size_t)L * DM * INW, INW, 512, 768, DM, (bf16*)WL(ap, L, W_IN), 1024, scr, r, lane); continue; } r -= I_QKV;
            if (r < I_O) { p0_transpose_item(ap->in[7] + (size_t)L * DM * DM, DM, 0, DM, DM, (bf16*)WL(ap, L, W_OUT), 0, scr, r, lane); continue; } r -= I_O;
            if (r < I_1) { p0_transpose_item(ap->in[10] + (size_t)L * DM * DFF, DFF, 0, DFF, DM, (bf16*)WL(ap, L, W_FF1), 0, scr, r, lane); continue; } r -= I_1;
            p0_transpose_item(ap->in[11] + (size_t)L * DFF * DM, DM, 0, DM, DFF, (bf16*)WL(ap, L, W_FF2), 0, scr, r, lane);
        }
        { const float* x_prompt = ap->in[0]; const float* x_sample = ap->in[1]; const float* eg = ap->in[2]; const float* eb = ap->in[3]; bf16* X = XBUF(ap);
          for (int m = gw; m < MTOK; m += ngw) { const float* xr = m < MP ? x_prompt + (size_t)m * DM : x_sample + (size_t)(m - MP) * DM; ln_emb_row(xr, eg, eb, X + (size_t)m * DM, lane); } }
        make_tables(TABS(ap), bx * NTHR + tid, G * NTHR);
    }
    if (IN(0) && IN(1)) { grid.sync(); (void)xcd_barrier_post((unsigned*)get_args()->ws + 4096, (volatile LAS unsigned*)(lds + 131072 + 320) + 8); }
    for (int L = 0; L < 2; ++L) {
        const int pb = 1 + 8 * L;
        if (IN(pb + 0)) {
            ArgsP ap = get_args();
            pg8::Gemm g{XBUF(ap), WL(ap, L, W_IN), MTOK, NPROJ, DM}; pg8::StaticOrder S; S.init(MTOK, NPROJ, G, bx);
            pg8::EpiBf16<0> E{PROJBUF(ap), NPROJ, nullptr, 0, 0, 1.f};
            pg8::gemm_phase<pg8::EpiBf16<0>, pg8::StaticOrder, true, true>(lds, g, S, E);
        }
        SEAM(pb + 0);
        for (int rep = 0; rep < DUP_MIX + DUP_ATT; ++rep) if (IN(pb + 1)) {
            FRESH(); ArgsP ap = get_args();
            const float* sink = ap->in[6] + L * 8; const bf16* PROJ = PROJBUF(ap); bf16* HEADS = HEADSBUF(ap); bf16* ZP = ZPBUF(ap); const unsigned char* tabs = TABS(ap);
            constexpr int NATT = 1280, NF1P = 4096, NF1S = 512;
            for (int t = bx; t < (rep >= DUP_MIX ? NATT : NATT + NF1P + NF1S); t += G) {
                if (t < NATT) {
                    if (t < 1024) { const int kv = t & 1, n = (t >> 1) & 31, b = t >> 6; attn_task(lds, PROJ, HEADS, sink, (size_t)b * SP, SP, n, kv, tid); }
                    else { const int u = t - 1024, kv = u & 1, n = u >> 1; attn_task(lds, PROJ, HEADS, sink, (size_t)MP, SS, n, kv, tid); }
                } else if (t < NATT + NF1P) { const int u = t - NATT, g = u & 3, s2 = (u >> 2) & 63, b = u >> 8;
                    fft1_task<64>(lds, PROJ, ZP, (const bf16*)(tabs + T_A1P), (const float2*)(tabs + T_TWP), (size_t)b * SP, s2, g, tid);
                } else { const int u = t - NATT - NF1P, g = u & 3, s2 = u >> 2;
                    fft1_task<128>(lds, PROJ, ZP, (const bf16*)(tabs + T_A1S), (const float2*)(tabs + T_TWS), (size_t)MP, s2, g, tid); }
            }
        }
        SEAM(pb + 1);
        for (int rep = 0; rep < DUP_MIX; ++rep) if (IN(pb + 2)) {
            FRESH(); ArgsP ap = get_args();
            const bf16* ZP = ZPBUF(ap); bf16* HEADS = HEADSBUF(ap); const unsigned char* tabs = TABS(ap);
            for (int t = bx; t < 4096 + 512; t += G) {
                if (t < 4096) { const int g = t & 3, k1 = (t >> 2) & 63, b = t >> 8; fft2_task<64>(lds, ZP, HEADS, (const bf16*)(tabs + T_A2P), (size_t)b * SP, k1, g, tid); }
                else { const int u = t - 4096, g = u & 3, k1 = u >> 2; fft2_task<128>(lds, ZP, HEADS, (const bf16*)(tabs + T_A2S), (size_t)MP, k1, g, tid); }
            }
        }
        SEAM(pb + 2);
        if (IN(pb + 3)) {
            ArgsP ap = get_args();
            pg8::Gemm g{HEADSBUF(ap), WL(ap, L, W_OUT), MTOK, DM, DM}; pg8::StaticOrder S; S.init(MTOK, DM, G, bx);
            pg8::EpiRes E{XBUF(ap), ZBUF(ap), DM, ALPHA};
            pg8::gemm_phase<pg8::EpiRes, pg8::StaticOrder, true, true>(lds, g, S, E);
        }
        SEAM(pb + 3);
        for (int rep = 0; rep < DUP_LN; ++rep) if (IN(pb + 4)) { FRESH(); ArgsP ap = get_args(); ln_pass(ZBUF(ap), ap->in[8] + L * DM, ap->in[9] + L * DM, XBUF(ap), nullptr, bx * NWAVES + wave, G * NWAVES, lane); }
        SEAM(pb + 4);
        if (IN(pb + 5)) {
            ArgsP ap = get_args();
            pg8::Gemm g{XBUF(ap), WL(ap, L, W_FF1), MTOK, DFF, DM}; pg8::StaticOrder S; S.init(MTOK, DFF, G, bx);
            pg8::EpiBf16<2> E{HBUF(ap), DFF, nullptr, 0, 0, 1.f};
            pg8::gemm_phase<pg8::EpiBf16<2>, pg8::StaticOrder, true, true>(lds, g, S, E);
        }
        SEAM(pb + 5);
        if (IN(pb + 6)) {
            ArgsP ap = get_args();
            pg8::Gemm g{HBUF(ap), WL(ap, L, W_FF2), MTOK, DM, DFF}; pg8::StaticOrder S; S.init(MTOK, DM, G, bx);
            pg8::EpiRes E{XBUF(ap), ZBUF(ap), DM, ALPHA};
            pg8::gemm_phase<pg8::EpiRes, pg8::StaticOrder, true, true>(lds, g, S, E);
        }
        SEAM(pb + 6);
        for (int rep = 0; rep < DUP_LN; ++rep) if (IN(pb + 7)) { FRESH(); ArgsP ap = get_args(); ln_pass(ZBUF(ap), ap->in[12] + L * DM, ap->in[13] + L * DM, XBUF(ap), L == 1 ? ap->out : nullptr, bx * NWAVES + wave, G * NWAVES, lane); }
        if (L == 0) SEAM(pb + 7);
    }
#undef IN
#undef SEAM
}

#ifndef MK_ONE_LAUNCH
#define MK_ONE_LAUNCH 1
#endif
extern "C" void kernel_launch(void* const* d_in, const int* in_sizes, int n_in, void* d_out, int out_size, void* d_ws, size_t ws_size, hipStream_t stream) {
    static int grid = 0;
    if (grid == 0) {
        if (n_in != 14 || out_size != MTOK * DM || ws_size < WS_END) { fprintf(stderr, "kernel_launch: unexpected shapes (n_in %d, out %d, ws %zu); nothing launched\n", n_in, out_size, ws_size); grid = -1; return; }
        int dev = 0, cus = 0, per_cu = 0;
        hipGetDevice(&dev); hipDeviceGetAttribute(&cus, hipDeviceAttributeMultiprocessorCount, dev);
        if (hipFuncSetAttribute((const void*)hymba_fwd, hipFuncAttributeMaxDynamicSharedMemorySize, LDS_BYTES) != hipSuccess) { fprintf(stderr, "kernel_launch: hipFuncSetAttribute failed\n"); grid = -1; return; }
        if (hipOccupancyMaxActiveBlocksPerMultiprocessor(&per_cu, (const void*)hymba_fwd, NTHR, LDS_BYTES) != hipSuccess || per_cu < 1) { fprintf(stderr, "kernel_launch: occupancy query says %d\n", per_cu); per_cu = 1; }
        (void)hipGetLastError();
        grid = cus * per_cu;
        fprintf(stderr, "kernel_launch: grid %d (%d CUs x %d)\n", grid, cus, per_cu);
    }
    if (grid < 0) return;
    Args a{};
    for (int i = 0; i < 14; ++i) a.in[i] = (const float*)d_in[i];
    a.out = (float*)d_out; a.ws = (unsigned char*)d_ws;
#if MK_ONE_LAUNCH
    a.ph_lo = 0; a.ph_hi = NPHASE;
    void* kargs[] = {&a};
    hipError_t e = hipLaunchCooperativeKernel((const void*)hymba_fwd, dim3(grid), dim3(NTHR), kargs, LDS_BYTES, stream);
    if (e != hipSuccess) fprintf(stderr, "kernel_launch: cooperative launch failed: %s (grid %d)\n", hipGetErrorString(e), grid);
#else
    for (int p = 0; p < NPHASE; ++p) { a.ph_lo = p; a.ph_hi = p + 1; hipLaunchKernelGGL(hymba_fwd, dim3(grid), dim3(NTHR), LDS_BYTES, stream, a); }
#endif
}
```

```cpp
#include <hip/hip_runtime.h>
#include <hip/hip_cooperative_groups.h>
#include <cstdio>
#include <cstdint>
namespace cg = cooperative_groups;
namespace pg8 {
#define PG8_LAS __attribute__((address_space(3)))
typedef unsigned short bf16_t;
typedef short bf16x8 __attribute__((ext_vector_type(8)));
typedef float f32x4 __attribute__((ext_vector_type(4)));
typedef unsigned u32x4 __attribute__((ext_vector_type(4)));
constexpr int BM = 256, BK = 64, HALF = 128, HTB = HALF * BK * 2  , STAGE_BYTES = 8 * HTB, NXCD = 8, WGM = 8;

__host__ __device__ __forceinline__ int lds_byte(int r, int c) { const int st = (r >> 4) * 2 + (c >> 5), rr = r & 15, cc = c & 31, ob = rr * 64 + cc * 2; return st * 1024 + (ob ^ (((ob >> 9) & 1) << 5)); }
__host__ __device__ __forceinline__ void stage_rc(int b, int& R, int& C) { const int st = b / 1024, sb = b % 1024, swz = sb ^ (((sb >> 9) & 1) << 5); R = (st >> 1) * 16 + swz / 64; C = (st & 1) * 32 + (swz % 64) / 2; }
__host__ __device__ __forceinline__ int perm32(int rho) { const int n = rho >> 4, i = rho & 15; return 8 * (i >> 2) + 4 * n + (i & 3); }

struct Unit { int pm, pn; };
struct Gemm { const bf16_t* A; const bf16_t* Bt; int M, N, K; };

struct StaticOrder {
    int nM, nN, nwg, G, c;
    __host__ __device__ void init(int M, int N, int G_, int c_) { nM = M / BM; nN = N / BM; nwg = nM * nN; G = G_; c = c_; }
    __host__ __device__ bool next(int i, Unit& u) const {
        const long L = (long)i * G + c; if (L >= nwg) return false;
        int wgid = (int)L; { const int q = nwg / NXCD, r = nwg % NXCD, xcd = wgid % NXCD, off = wgid / NXCD; wgid = (xcd < r ? xcd * (q + 1) : r * (q + 1) + (xcd - r) * q) + off; }
        const int nig = WGM * nN, gid = wgid / nig, fm = gid * WGM, gsz = (nM - fm) < WGM ? (nM - fm) : WGM;
        u.pm = fm + ((wgid % nig) % gsz); u.pn = (wgid % nig) / gsz; return true;
    }
    __device__ __forceinline__ void a_ready(const Unit&) const {}
    __device__ __forceinline__ void done(const Unit&) const {}
};

__device__ __forceinline__ unsigned cvt_pk_bf16(float lo, float hi) { unsigned r; asm volatile("v_cvt_pk_bf16_f32 %0, %1, %2" : "=v"(r) : "v"(lo), "v"(hi)); return r; }
typedef float f32x2 __attribute__((ext_vector_type(2)));
__device__ __forceinline__ f32x2 gelu_pk(f32x2 v) {
    const f32x2 av = __builtin_elementwise_abs(v), d = av * 0.2316418882f + 1.0f;
    f32x2 t; t.x = __builtin_amdgcn_rcpf(d.x); t.y = __builtin_amdgcn_rcpf(d.y);
    f32x2 q = t * 0.5307027145f + (-0.7265760135f); q = q * t + 0.7107068705f; q = q * t + (-0.142248368f); q = q * t + 0.127414796f; q = q * t;
    const f32x2 s = (v * v) * (-0.72134752044f);
    f32x2 e; e.x = __builtin_amdgcn_exp2f(s.x); e.y = __builtin_amdgcn_exp2f(s.y);
    const f32x2 m = v * (q * e), r = v - m;
    f32x2 o; o.x = v.x < 0.f ? m.x : r.x; o.y = v.y < 0.f ? m.y : r.y; return o;
}

template <int ACT  > struct EpiBf16 {
    static constexpr bool PERM = true, AFTER_DRAIN = false; static_assert(ACT == 0 || ACT == 1 || ACT == 2, "EpiBf16: ACT is 0 (none), 1 (gelu_pk) or 2 (squared relu)");
    bf16_t* O; int ldc; const float* bias; int split_cols; size_t split_stride; float scale0;
    __device__ __forceinline__ void operator()(const f32x4 (&acc)[2][2][4][2], const Unit& u, int wr, int wc, int fr, int fq) const {
        const int row0 = u.pm * BM + wr * 64 + fr; int colt = u.pn * BM; bf16_t* base = O;
        float sc = 1.f; if (split_cols) { const int t = colt / split_cols; base += (size_t)t * split_stride; colt -= t * split_cols; if (t == 0) sc = scale0; }
        const int col0 = colt + wc * 32 + 8 * fq, bcol0 = u.pn * BM + wc * 32 + 8 * fq;
        f32x4 bv[2][2];
#pragma unroll
        for (int bj = 0; bj < 2; ++bj)
#pragma unroll
            for (int n = 0; n < 2; ++n) bv[bj][n] = bias ? *(const f32x4*)(bias + bcol0 + bj * HALF + 4 * n) : (f32x4){0.f, 0.f, 0.f, 0.f};
#pragma unroll
        for (int ai = 0; ai < 2; ++ai)
#pragma unroll
            for (int m = 0; m < 4; ++m) { bf16_t* rowp = base + (size_t)(row0 + ai * HALF + m * 16) * ldc + col0;
#pragma unroll
                for (int bj = 0; bj < 2; ++bj) { f32x4 v0 = acc[ai][bj][m][0] + bv[bj][0], v1 = acc[ai][bj][m][1] + bv[bj][1];
                    if (ACT == 1) { f32x2 a = gelu_pk((f32x2){v0[0], v0[1]}), b = gelu_pk((f32x2){v0[2], v0[3]}), c = gelu_pk((f32x2){v1[0], v1[1]}), d = gelu_pk((f32x2){v1[2], v1[3]});
                        v0 = (f32x4){a.x, a.y, b.x, b.y}; v1 = (f32x4){c.x, c.y, d.x, d.y}; }
                    if (ACT == 2) { v0 = __builtin_elementwise_max(v0, (f32x4){0.f,0.f,0.f,0.f}); v1 = __builtin_elementwise_max(v1, (f32x4){0.f,0.f,0.f,0.f}); v0 = v0 * v0; v1 = v1 * v1; }
                    v0 = v0 * sc; v1 = v1 * sc; u32x4 w; w.x = cvt_pk_bf16(v0[0], v0[1]); w.y = cvt_pk_bf16(v0[2], v0[3]); w.z = cvt_pk_bf16(v1[0], v1[1]); w.w = cvt_pk_bf16(v1[2], v1[3]);
                    *(u32x4*)(rowp + bj * HALF) = w; } }
    }
};

struct PanelStats {
    unsigned* xbuf;
    unsigned* cnt;
    unsigned* tmo;
    int ntn; float eps;
    unsigned code;
    __device__ __forceinline__ bool run(const f32x4 (&v)[2][2][4][2], const Unit& u, int wr, int wc, int fr, int fq, PG8_LAS unsigned char* lds, int wid, int lane) const {
        typedef float f32x2v __attribute__((ext_vector_type(2)));
        PG8_LAS f32x2v* P = (PG8_LAS f32x2v*)lds;
        PG8_LAS f32x2v* S = (PG8_LAS f32x2v*)(lds + 8192);
        PG8_LAS unsigned* flag = (PG8_LAS unsigned*)(lds + 8192 + 2048);
#pragma unroll
        for (int ai = 0; ai < 2; ++ai)
#pragma unroll
            for (int m = 0; m < 4; ++m) {
                float s = 0.f;
#pragma unroll
                for (int bj = 0; bj < 2; ++bj)
#pragma unroll
                    for (int n = 0; n < 2; ++n) { const f32x4 x = v[ai][bj][m][n]; s += (x[0] + x[1]) + (x[2] + x[3]); }
                s += __shfl_xor(s, 16); s += __shfl_xor(s, 32);
                const float mw = s * (1.0f / 64.0f); float q = 0.f;
#pragma unroll
                for (int bj = 0; bj < 2; ++bj)
#pragma unroll
                    for (int n = 0; n < 2; ++n) { const f32x4 d = v[ai][bj][m][n] - mw; q += (d[0] * d[0] + d[1] * d[1]) + (d[2] * d[2] + d[3] * d[3]); }
                q += __shfl_xor(q, 16); q += __shfl_xor(q, 32);
                if (fq == 0) P[(ai * HALF + wr * 64 + m * 16 + fr) * 4 + wc] = (f32x2v){mw, q};
            }
        asm volatile("s_waitcnt lgkmcnt(0)" ::: "memory"); __builtin_amdgcn_s_barrier(); asm volatile("" ::: "memory");
#if defined(BROKEN_EXCHANGE_NO_WAIT)
#warning BROKEN CONTROL BUILD: the row-statistics exchange does not wait; results are wrong by design
        if (blockIdx.x >= 64) { const long long t0_ = clock64(); while (clock64() - t0_ < 60000) __builtin_amdgcn_s_sleep(8); }
#endif
        const int row = wid * 32 + (lane & 31);
        if (lane < 32) {
            const f32x2v a = P[row * 4 + 0], b = P[row * 4 + 1], c = P[row * 4 + 2], d = P[row * 4 + 3];
            const float mt = (a.x + b.x + c.x + d.x) * 0.25f;
            const float da = a.x - mt, db = b.x - mt, dc = c.x - mt, dd = d.x - mt;
            const float m2 = (a.y + b.y) + (c.y + d.y) + 64.0f * ((da * da + db * db) + (dc * dc + dd * dd));
            unsigned long long* slot = (unsigned long long*)xbuf + ((size_t)(u.pm * BM + row) * 4 + u.pn);
            __hip_atomic_store(slot, ((unsigned long long)__float_as_uint(m2) << 32) | __float_as_uint(mt), __ATOMIC_RELAXED, __HIP_MEMORY_SCOPE_AGENT);
        }
        asm volatile("s_waitcnt vmcnt(0)" ::: "memory");
        if (lane == 0) __hip_atomic_fetch_add(cnt + 64 * u.pm, 1u, __ATOMIC_RELAXED, __HIP_MEMORY_SCOPE_AGENT);
        if (wid == 0) {
            bool dead = false; const unsigned long long t0 = __builtin_amdgcn_s_memrealtime(); const unsigned want = 8u * (unsigned)ntn;
            for (;;) {
#if defined(BROKEN_EXCHANGE_NO_WAIT)
                break;
#endif
                if ((unsigned)__builtin_amdgcn_readfirstlane(__hip_atomic_load(cnt + 64 * u.pm, __ATOMIC_RELAXED, __HIP_MEMORY_SCOPE_AGENT)) >= want) break;
                if (__builtin_amdgcn_s_memrealtime() - t0 > 2000000ull) {
                    if (lane == 0) { unsigned expect = 0u; __hip_atomic_compare_exchange_strong(tmo + 1, &expect, code | (unsigned)(u.pm & 0xff), __ATOMIC_RELAXED, __ATOMIC_RELAXED, __HIP_MEMORY_SCOPE_AGENT);
                                     __hip_atomic_store(tmo, 1u, __ATOMIC_RELAXED, __HIP_MEMORY_SCOPE_AGENT); }
                    dead = true; break; }
                __builtin_amdgcn_s_sleep(2);
            }
            __builtin_amdgcn_fence(__ATOMIC_ACQUIRE, "agent");
            if (lane == 0) flag[0] = dead ? 1u : 0u;
        }
        asm volatile("s_waitcnt vmcnt(0) lgkmcnt(0)" ::: "memory"); __builtin_amdgcn_s_barrier(); asm volatile("" ::: "memory");
        const bool bad = flag[0] != 0u;
        if (lane < 32) {
            const unsigned long long* slot = (const unsigned long long*)xbuf + (size_t)(u.pm * BM + row) * 4; float mt[4], m2[4]; float ms = 0.f;
#pragma unroll
            for (int t = 0; t < 4; ++t) { if (t < ntn) { const unsigned long long w = __hip_atomic_load(slot + t, __ATOMIC_RELAXED, __HIP_MEMORY_SCOPE_AGENT); mt[t] = __uint_as_float((unsigned)w); m2[t] = __uint_as_float((unsigned)(w >> 32)); } else { mt[t] = 0.f; m2[t] = 0.f; } ms += mt[t]; }
            const float mean = ms / (float)ntn; float q = 0.f;
#pragma unroll
            for (int t = 0; t < 4; ++t) if (t < ntn) { const float dm = mt[t] - mean; q += m2[t] + 256.0f * dm * dm; }
            S[row] = (f32x2v){mean, 1.0f / sqrtf(q / (256.0f * (float)ntn) + eps)};
        }
        asm volatile("s_waitcnt lgkmcnt(0)" ::: "memory"); __builtin_amdgcn_s_barrier(); asm volatile("" ::: "memory");
        return bad;
    }
};
struct EpiLnRes {
    static constexpr bool PERM = false, AFTER_DRAIN = true;
    const float* base; float* out; int ldc; const float* bias; PanelStats st; unsigned poison;
    __device__ __forceinline__ void fused(f32x4 (&acc)[2][2][4][2], const Unit& u, int wr, int wc, int fr, int fq, PG8_LAS unsigned char* lds, int wid, int lane) const {
        typedef float f32x2v __attribute__((ext_vector_type(2)));
        const PG8_LAS f32x2v* S = (const PG8_LAS f32x2v*)(lds + 8192);
        const int col0 = u.pn * BM + wc * 32 + 4 * fq;
#pragma unroll
        for (int bj = 0; bj < 2; ++bj)
#pragma unroll
            for (int n = 0; n < 2; ++n) { const f32x4 bv = bias ? *(const f32x4*)(bias + col0 + bj * HALF + n * 16) : (f32x4){0.f, 0.f, 0.f, 0.f};
#pragma unroll
                for (int ai = 0; ai < 2; ++ai)
#pragma unroll
                    for (int m = 0; m < 4; ++m) acc[ai][bj][m][n] += bv; }
        f32x4 pre[4][2][2];
#pragma unroll
        for (int m = 0; m < 4; ++m) { const size_t off = (size_t)(u.pm * BM + wr * 64 + m * 16 + fr) * ldc + col0;
#pragma unroll
            for (int bj = 0; bj < 2; ++bj)
#pragma unroll
                for (int n = 0; n < 2; ++n) pre[m][bj][n] = *(const f32x4*)(base + off + bj * HALF + n * 16); }
        const bool bad = st.run(acc, u, wr, wc, fr, fq, lds, wid, lane) || poison != 0u;
        const float qnan = __builtin_nanf("");
#pragma unroll
        for (int ai = 0; ai < 2; ++ai)
#pragma unroll
            for (int m = 0; m < 4; ++m) { const int r = ai * HALF + wr * 64 + m * 16 + fr; const f32x2v sr = S[r]; const size_t off = (size_t)(u.pm * BM + r) * ldc + col0;
#pragma unroll
                for (int bj = 0; bj < 2; ++bj)
#pragma unroll
                    for (int n = 0; n < 2; ++n) { const f32x4 bs = ai == 0 ? pre[m][bj][n] : *(const f32x4*)(base + off + bj * HALF + n * 16); f32x4 o = bs + (acc[ai][bj][m][n] - sr.x) * sr.y;
                        if (bad) o = (f32x4){qnan, qnan, qnan, qnan}; *(f32x4*)(out + off + bj * HALF + n * 16) = o; }
                if (m & 1) asm volatile("" ::: "memory"); }
    }
};
struct EpiLnResLn {
    static constexpr bool PERM = false, AFTER_DRAIN = true;
    const float* base; float* out; bf16_t* xn; int ldc; const float* bias; PanelStats st1, st2; unsigned poison;
    __device__ __forceinline__ void fused(f32x4 (&acc)[2][2][4][2], const Unit& u, int wr, int wc, int fr, int fq, PG8_LAS unsigned char* lds, int wid, int lane) const {
        typedef float f32x2v __attribute__((ext_vector_type(2))); typedef unsigned u32x2v __attribute__((ext_vector_type(2)));
        const PG8_LAS f32x2v* S = (const PG8_LAS f32x2v*)(lds + 8192);
        const int col0 = u.pn * BM + wc * 32 + 4 * fq;
#pragma unroll
        for (int bj = 0; bj < 2; ++bj)
#pragma unroll
            for (int n = 0; n < 2; ++n) { const f32x4 bv = bias ? *(const f32x4*)(bias + col0 + bj * HALF + n * 16) : (f32x4){0.f, 0.f, 0.f, 0.f};
#pragma unroll
                for (int ai = 0; ai < 2; ++ai)
#pragma unroll
                    for (int m = 0; m < 4; ++m) acc[ai][bj][m][n] += bv; }
        bool bad = st1.run(acc, u, wr, wc, fr, fq, lds, wid, lane) || poison != 0u;
        const float qnan = __builtin_nanf("");
#pragma unroll
        for (int ai = 0; ai < 2; ++ai)
#pragma unroll
            for (int m = 0; m < 4; ++m) { const int r = ai * HALF + wr * 64 + m * 16 + fr; const f32x2v sr = S[r]; const size_t off = (size_t)(u.pm * BM + r) * ldc + col0;
#pragma unroll
                for (int bj = 0; bj < 2; ++bj)
#pragma unroll
                    for (int n = 0; n < 2; ++n) { const f32x4 bs = *(const f32x4*)(base + off + bj * HALF + n * 16); acc[ai][bj][m][n] = bs + (acc[ai][bj][m][n] - sr.x) * sr.y; }
                asm volatile("" : "+v"(acc[ai][0][m][0]), "+v"(acc[ai][0][m][1]), "+v"(acc[ai][1][m][0]), "+v"(acc[ai][1][m][1]));
                if (m & 1) asm volatile("" ::: "memory"); }
        const bool bad1 = bad;
        bad = st2.run(acc, u, wr, wc, fr, fq, lds, wid, lane) || bad;
#pragma unroll
        for (int ai = 0; ai < 2; ++ai)
#pragma unroll
            for (int m = 0; m < 4; ++m) { const int r = ai * HALF + wr * 64 + m * 16 + fr; const f32x2v sr = S[r]; const size_t off = (size_t)(u.pm * BM + r) * ldc + col0;
#pragma unroll
                for (int bj = 0; bj < 2; ++bj)
#pragma unroll
                    for (int n = 0; n < 2; ++n) { const f32x4 x1 = acc[ai][bj][m][n]; *(f32x4*)(out + off + bj * HALF + n * 16) = bad1 ? (f32x4){qnan, qnan, qnan, qnan} : x1;
                        const f32x4 o = (x1 - sr.x) * sr.y; u32x2v w; w.x = cvt_pk_bf16(o[0], o[1]); w.y = cvt_pk_bf16(o[2], o[3]);
                        if (bad) { w.x = 0x7fc07fc0u; w.y = 0x7fc07fc0u; } *(u32x2v*)(xn + off + bj * HALF + n * 16) = w; }
                asm volatile("" ::: "memory"); }
    }
};

template <class Epi, class Sched, bool ALIGN_EPI = false, bool SP2 = false>
__device__ __forceinline__ void gemm_phase(PG8_LAS unsigned char* lds, const Gemm g, const Sched& S, const Epi& E) {
    int tid_ = threadIdx.x; asm volatile("" : "+v"(tid_));
    const int tid = tid_, wid = __builtin_amdgcn_readfirstlane(tid >> 6), lane = tid & 63, wr = wid >> 2, wc = wid & 3, fr = lane & 15, fq = lane >> 4;
    const int K = g.K, nt = K / BK;
    unsigned voffA[2], voffB[2];
#pragma unroll
    for (int i = 0; i < 2; ++i) { int R, C; stage_rc(tid * 16 + i * 8192, R, C); const int Rb = Epi::PERM ? ((R & ~31) + perm32(R & 31)) : R;
        voffA[i] = (unsigned)(R * K + C) * 2u; voffB[i] = (unsigned)(Rb * K + C) * 2u; }
    const size_t kstep = (size_t)(BK * 2);
    const size_t hstep = (size_t)HALF * K * 2;
    const size_t tstep = 2 * hstep;
    const unsigned ldsw = (unsigned)wid * 1024u;
    const int aoff = lds_byte(wr * 64 + fr, fq * 8), boff = lds_byte(wc * 32 + fr, fq * 8);
#define PG8_SA(b, h) (((b) * 2 + (h)) * HTB)
#define PG8_SB(b, h) ((4 + (b) * 2 + (h)) * HTB)
#define PG8_STAGE(bufoff, gbase, voff) do { _Pragma("unroll") for (int _i = 0; _i < 2; ++_i) \
        __builtin_amdgcn_global_load_lds((const unsigned*)((const char*)(gbase) + (voff)[_i]), (PG8_LAS unsigned*)(lds + (bufoff) + ldsw + _i * 8192), 16, 0, 0); } while (0)
#define PG8_LDA(dst, b, h) do { _Pragma("unroll") for (int m = 0; m < 4; ++m) _Pragma("unroll") for (int k = 0; k < 2; ++k) dst[m][k] = *(const PG8_LAS bf16x8*)(lds + PG8_SA(b, h) + aoff + m * 2048 + k * 1024); } while (0)
#define PG8_LDB(dst, b, h) do { _Pragma("unroll") for (int n = 0; n < 2; ++n) _Pragma("unroll") for (int k = 0; k < 2; ++k) dst[n][k] = *(const PG8_LAS bf16x8*)(lds + PG8_SB(b, h) + boff + n * 2048 + k * 1024); } while (0)
#define PG8_MMA(ai, bj, At, Bt) do { __builtin_amdgcn_s_setprio(1); _Pragma("unroll") for (int m = 0; m < 4; ++m) _Pragma("unroll") for (int n = 0; n < 2; ++n) _Pragma("unroll") for (int k = 0; k < 2; ++k) \
        acc[ai][bj][m][n] = __builtin_amdgcn_mfma_f32_16x16x32_bf16(Bt[n][k], At[m][k], acc[ai][bj][m][n], 0, 0, 0); __builtin_amdgcn_s_setprio(0); } while (0)
#define PG8_WAIT_V(n) asm volatile("s_waitcnt vmcnt(" #n ")" ::: "memory")
#define PG8_WAIT_L(n) asm volatile("s_waitcnt lgkmcnt(" #n ")" ::: "memory")
#define PG8_BAR __builtin_amdgcn_s_barrier()
#define PG8_SCHED __builtin_amdgcn_sched_barrier(0)
    Unit cur, nxt; int ui = 0;
    if (!S.next(0, cur)) return;
    f32x4 acc[2][2][4][2];
#pragma unroll
    for (int a = 0; a < 2; ++a)
#pragma unroll
        for (int b = 0; b < 2; ++b)
#pragma unroll
            for (int m = 0; m < 4; ++m)
#pragma unroll
                for (int n = 0; n < 2; ++n) acc[a][b][m][n] = (f32x4){0.f, 0.f, 0.f, 0.f};
    bf16x8 At[4][2], B0[2][2], B1[2][2];
    const char* cA = (const char*)g.A + (size_t)cur.pm * tstep; const char* cB = (const char*)g.Bt + (size_t)cur.pn * tstep;
    S.a_ready(cur);
    if constexpr (SP2) {
        PG8_STAGE(PG8_SB(0, 0), cB, voffB); PG8_STAGE(PG8_SB(0, 1), cB + hstep, voffB); PG8_STAGE(PG8_SA(0, 0), cA, voffA); PG8_STAGE(PG8_SA(0, 1), cA + hstep, voffA);
        if (wr == 1) PG8_BAR;
        PG8_WAIT_V(2); PG8_BAR;
        PG8_STAGE(PG8_SB(1, 0), cB + kstep, voffB); PG8_STAGE(PG8_SA(1, 0), cA + kstep, voffA); PG8_STAGE(PG8_SB(1, 1), cB + hstep + kstep, voffB);
        PG8_WAIT_V(6); PG8_BAR;
    } else {
        PG8_STAGE(PG8_SB(0, 0), cB, voffB); PG8_STAGE(PG8_SA(0, 0), cA, voffA); PG8_STAGE(PG8_SB(0, 1), cB + hstep, voffB); PG8_STAGE(PG8_SA(0, 1), cA + hstep, voffA);
        if (wr == 1) PG8_BAR;
        PG8_WAIT_V(4); PG8_BAR;
        PG8_STAGE(PG8_SB(1, 0), cB + kstep, voffB); PG8_STAGE(PG8_SA(1, 0), cA + kstep, voffA); PG8_STAGE(PG8_SB(1, 1), cB + hstep + kstep, voffB);
        PG8_WAIT_V(6); PG8_BAR;
    }
    for (;;) {
        const bool has_next = S.next(ui + 1, nxt);
        const char* nA = has_next ? (const char*)g.A + (size_t)nxt.pm * tstep : cA; const char* nB = has_next ? (const char*)g.Bt + (size_t)nxt.pn * tstep : cB;
        for (int t = 0; t < nt; t += 2) {
            const bool last = (t == nt - 2);
            const char* a1 = cA + (size_t)(t + 1) * kstep;
            const char* a2 = last ? nA : cA + (size_t)(t + 2) * kstep; const char* b2 = last ? nB : cB + (size_t)(t + 2) * kstep;
            const char* a3 = a2 + kstep; const char* b3 = b2 + kstep;
            if (last && has_next) S.a_ready(nxt);
            if constexpr (SP2) {
            PG8_LDB(B0, 0, 0); PG8_LDB(B1, 0, 1); PG8_SCHED; PG8_LDA(At, 0, 0); PG8_STAGE(PG8_SA(1, 1), a1 + hstep, voffA);
            PG8_WAIT_V(8); PG8_WAIT_L(0); PG8_BAR; PG8_MMA(0, 0, At, B0); PG8_MMA(0, 1, At, B1); PG8_BAR; PG8_SCHED;
            PG8_LDA(At, 0, 1); PG8_STAGE(PG8_SB(0, 0), b2, voffB); PG8_STAGE(PG8_SB(0, 1), b2 + hstep, voffB); PG8_STAGE(PG8_SA(0, 0), a2, voffA);
            PG8_WAIT_V(8); PG8_WAIT_L(0); PG8_BAR; PG8_MMA(1, 0, At, B0); PG8_MMA(1, 1, At, B1); PG8_BAR; PG8_SCHED;
            PG8_LDB(B0, 1, 0); PG8_LDB(B1, 1, 1); PG8_SCHED; PG8_LDA(At, 1, 0); PG8_STAGE(PG8_SA(0, 1), a2 + hstep, voffA);
            PG8_WAIT_V(8); PG8_WAIT_L(0); PG8_BAR; PG8_MMA(0, 0, At, B0); PG8_MMA(0, 1, At, B1); PG8_BAR; PG8_SCHED;
            PG8_LDA(At, 1, 1); PG8_STAGE(PG8_SB(1, 0), b3, voffB); PG8_STAGE(PG8_SB(1, 1), b3 + hstep, voffB); PG8_STAGE(PG8_SA(1, 0), a3, voffA);
            PG8_WAIT_V(8); PG8_WAIT_L(0); PG8_BAR; PG8_MMA(1, 0, At, B0); PG8_MMA(1, 1, At, B1); PG8_BAR; PG8_SCHED;
            } else {
            PG8_LDB(B0, 0, 0); PG8_SCHED; PG8_LDA(At, 0, 0); PG8_STAGE(PG8_SA(1, 1), a1 + hstep, voffA);
            PG8_WAIT_L(8); PG8_BAR; PG8_WAIT_L(0); PG8_MMA(0, 0, At, B0); PG8_BAR; PG8_SCHED;
            PG8_LDB(B1, 0, 1); PG8_STAGE(PG8_SB(0, 0), b2, voffB);
            PG8_BAR; PG8_WAIT_L(0); PG8_MMA(0, 1, At, B1); PG8_BAR;
            PG8_LDA(At, 0, 1); PG8_STAGE(PG8_SA(0, 0), a2, voffA);
            PG8_BAR; PG8_WAIT_L(0); PG8_MMA(1, 0, At, B0); PG8_BAR; PG8_SCHED;
            PG8_STAGE(PG8_SB(0, 1), b2 + hstep, voffB);
            PG8_WAIT_V(6); PG8_BAR; PG8_MMA(1, 1, At, B1); PG8_BAR;
            PG8_LDB(B0, 1, 0); PG8_SCHED; PG8_LDA(At, 1, 0); PG8_STAGE(PG8_SA(0, 1), a2 + hstep, voffA);
            PG8_WAIT_L(8); PG8_BAR; PG8_WAIT_L(0); PG8_MMA(0, 0, At, B0); PG8_BAR; PG8_SCHED;
            PG8_LDB(B1, 1, 1); PG8_STAGE(PG8_SB(1, 0), b3, voffB);
            PG8_BAR; PG8_WAIT_L(0); PG8_MMA(0, 1, At, B1); PG8_BAR;
            PG8_LDA(At, 1, 1); PG8_STAGE(PG8_SA(1, 0), a3, voffA);
            PG8_BAR; PG8_WAIT_L(0); PG8_MMA(1, 0, At, B0); PG8_BAR; PG8_SCHED;
            PG8_STAGE(PG8_SB(1, 1), b3 + hstep, voffB);
            PG8_WAIT_V(6); PG8_BAR; PG8_MMA(1, 1, At, B1); PG8_BAR;
            }
        }
        if constexpr (ALIGN_EPI) { if (wr == 0) PG8_BAR; }
        if constexpr (!Epi::AFTER_DRAIN) { E(acc, cur, wr, wc, fr, fq); S.done(cur); }
        if (!has_next) break;
#pragma unroll
        for (int a = 0; a < 2; ++a)
#pragma unroll
            for (int b = 0; b < 2; ++b)
#pragma unroll
                for (int m = 0; m < 4; ++m)
#pragma unroll
                    for (int n = 0; n < 2; ++n) acc[a][b][m][n] = (f32x4){0.f, 0.f, 0.f, 0.f};
        cur = nxt; cA = nA; cB = nB; ++ui;
        if constexpr (ALIGN_EPI) { if (wr == 1) PG8_BAR; }
    }
    PG8_WAIT_V(0);
    if constexpr (!ALIGN_EPI) { if (wr == 0) PG8_BAR; }
    PG8_BAR;
    if constexpr (Epi::AFTER_DRAIN) { E.fused(acc, cur, wr, wc, fr, fq, lds, wid, lane); S.done(cur); }
#undef PG8_SA
#undef PG8_SB
#undef PG8_STAGE
#undef PG8_LDA
#undef PG8_LDB
#undef PG8_MMA
#undef PG8_WAIT_V
#undef PG8_WAIT_L
#undef PG8_BAR
#undef PG8_SCHED
}
}

namespace pg8 {
struct EpiRes {
    static constexpr bool PERM = true, AFTER_DRAIN = false;
    const bf16_t* X; bf16_t* O; int ldc; float alpha;
    __device__ __forceinline__ void operator()(const f32x4 (&acc)[2][2][4][2], const Unit& u, int wr, int wc, int fr, int fq) const {
        const int row0 = u.pm * BM + wr * 64 + fr, col0 = u.pn * BM + wc * 32 + 8 * fq;
#pragma unroll
        for (int ai = 0; ai < 2; ++ai)
#pragma unroll
            for (int m = 0; m < 4; ++m) { const size_t off = (size_t)(row0 + ai * HALF + m * 16) * ldc + col0;
#pragma unroll
                for (int bj = 0; bj < 2; ++bj) { const u32x4 xv = *(const u32x4*)(X + off + bj * HALF);
                    f32x4 x0, x1;
                    x0[0] = __uint_as_float(xv.x << 16); x0[1] = __uint_as_float(xv.x & 0xffff0000u); x0[2] = __uint_as_float(xv.y << 16); x0[3] = __uint_as_float(xv.y & 0xffff0000u);
                    x1[0] = __uint_as_float(xv.z << 16); x1[1] = __uint_as_float(xv.z & 0xffff0000u); x1[2] = __uint_as_float(xv.w << 16); x1[3] = __uint_as_float(xv.w & 0xffff0000u);
                    const f32x4 v0 = x0 * alpha + acc[ai][bj][m][0], v1 = x1 * alpha + acc[ai][bj][m][1];
                    u32x4 w; w.x = cvt_pk_bf16(v0[0], v0[1]); w.y = cvt_pk_bf16(v0[2], v0[3]); w.z = cvt_pk_bf16(v1[0], v1[1]); w.w = cvt_pk_bf16(v1[2], v1[3]);
                    *(u32x4*)(O + off + bj * HALF) = w; } }
    }
};
}

#define LAS __attribute__((address_space(3)))
typedef unsigned short bf16;
typedef short bf16x8 __attribute__((ext_vector_type(8)));
typedef short s16x4 __attribute__((ext_vector_type(4)));
typedef float f32x4 __attribute__((ext_vector_type(4)));
typedef float f32x16 __attribute__((ext_vector_type(16)));
typedef unsigned u32x4 __attribute__((ext_vector_type(4)));
typedef unsigned u32x2 __attribute__((ext_vector_type(2)));

constexpr int DM = 1024, MP = 65536, MS = 16384, MTOK = MP + MS, SP = 4096, SS = 16384, DFF = 4096;
constexpr int NPROJ = 1792;
constexpr int INW = 1280;
constexpr float LN_EPS = 1e-5f;
constexpr float ALPHA = 1.4142135623730951f;
constexpr float LOG2E = 1.4426950408889634f;
constexpr int NWAVES = 8, NTHR = 512;
constexpr int LDS_BYTES = 147456;

constexpr size_t MiB = 1u << 20;
constexpr size_t WS_TAB = 1 * MiB;
constexpr size_t T_A1P = 0, T_A1S = 32768, T_A2P = 163840, T_A2S = 180224, T_TWP = 245760, T_TWS = 278528;
constexpr size_t WS_W = 2 * MiB, W_LAYER = 22 * MiB, W_IN = 0, W_OUT = 4 * MiB, W_FF1 = 6 * MiB, W_FF2 = 14 * MiB;
constexpr size_t WS_X = 48 * MiB, WS_Z = 208 * MiB, WS_H = 368 * MiB, WS_PROJ = 368 * MiB, WS_END = 1008 * MiB;

__device__ __forceinline__ unsigned f2bf(float f) { unsigned u = __builtin_bit_cast(unsigned, f); return (u + 0x7fffu + ((u >> 16) & 1u)) >> 16; }
__device__ __forceinline__ unsigned pk2(float lo, float hi) { return f2bf(lo) | (f2bf(hi) << 16); }
__device__ __forceinline__ float bflo(unsigned u) { return __uint_as_float(u << 16); }
__device__ __forceinline__ float bfhi(unsigned u) { return __uint_as_float(u & 0xffff0000u); }
__device__ __forceinline__ float wave_sum(float v) {
#pragma unroll
    for (int o = 1; o < 64; o <<= 1) v += __shfl_xor(v, o);
    return v;
}
__device__ __forceinline__ s16x4 vtr(const LAS unsigned char* p) { return __builtin_bit_cast(s16x4, __builtin_amdgcn_ds_read_tr16_b64_v4i16((LAS s16x4*)p)); }
__device__ __forceinline__ bf16x8 cat8(s16x4 lo, s16x4 hi) { return (bf16x8){lo[0], lo[1], lo[2], lo[3], hi[0], hi[1], hi[2], hi[3]}; }
#define LDS_WAIT() asm volatile("s_waitcnt lgkmcnt(0)" ::: "memory")
__device__ __forceinline__ unsigned cvtpk(float lo, float hi) { typedef float f2 __attribute__((ext_vector_type(2))); typedef __bf16 b2 __attribute__((ext_vector_type(2))); f2 v = {lo, hi}; b2 b = __builtin_convertvector(v, b2); return __builtin_bit_cast(unsigned, b); }

__device__ __forceinline__ void p0_transpose_item(const float* W, int ldw, int col_off, int ncols, int K, bf16* WT, int row_off, LAS float* scr, int item, int lane) {
    const int nblk = ncols / 32, kb = item / nblk, nb = item % nblk, k0 = 64 * kb, n0 = 32 * nb;
#pragma unroll 8
    for (int i = 0; i < 32; ++i) { const int kk = 2 * i + (lane >> 5); scr[kk * 33 + (lane & 31)] = W[(size_t)(k0 + kk) * ldw + col_off + n0 + (lane & 31)]; }
    LDS_WAIT(); asm volatile("" ::: "memory");
    const int c = lane & 7;
#pragma unroll
    for (int j = 0; j < 4; ++j) { const int n = (lane >> 3) + 8 * j; const LAS float* s = scr + (8 * c) * 33 + n;
        u32x4 o; o.x = pk2(s[0 * 33], s[1 * 33]); o.y = pk2(s[2 * 33], s[3 * 33]); o.z = pk2(s[4 * 33], s[5 * 33]); o.w = pk2(s[6 * 33], s[7 * 33]);
        *(u32x4*)(WT + (size_t)(row_off + n0 + n) * K + k0 + 8 * c) = o; }
    LDS_WAIT(); asm volatile("" ::: "memory");
}
__device__ __forceinline__ void ln_emb_row(const float* xrow, const float* g, const float* b, bf16* orow, int lane) {
    const f32x4* xr = (const f32x4*)xrow + lane;
    f32x4 v[4]; float s = 0.f;
#pragma unroll
    for (int j = 0; j < 4; ++j) { v[j] = xr[64 * j]; s += (v[j].x + v[j].y) + (v[j].z + v[j].w); }
    const float mean = wave_sum(s) * (1.f / DM); float s2 = 0.f;
#pragma unroll
    for (int j = 0; j < 4; ++j) { v[j] = v[j] - mean; s2 += (v[j].x * v[j].x + v[j].y * v[j].y) + (v[j].z * v[j].z + v[j].w * v[j].w); }
    const float rstd = 1.f / sqrtf(wave_sum(s2) * (1.f / DM) + LN_EPS);
    u32x2* o8 = (u32x2*)orow + lane;
#pragma unroll
    for (int j = 0; j < 4; ++j) { const f32x4 gg = ((const f32x4*)g)[lane + 64 * j], bb = ((const f32x4*)b)[lane + 64 * j]; const f32x4 y = v[j] * rstd * gg + bb;
        u32x2 w; w.x = pk2(y.x, y.y); w.y = pk2(y.z, y.w); o8[64 * j] = w; }
}
__device__ __forceinline__ void fold_task(LAS unsigned char* lds, const float* w_in_l, const float* wf_l, bf16* wt_in_l, int task, int tid) {
    LAS float* tab = (LAS float*)lds;
    LAS float* Mt = (LAS float*)(lds + 1024);
    LAS float* At = (LAS float*)(lds + 1024 + 32768);
    const int kt = task >> 4, cb = task & 15, g = cb >> 2, ri = (cb >> 1) & 1, eh = cb & 1;
    if (tid < 128) tab[tid] = cospif((float)tid * (1.0f / 64.0f));
    for (int i = tid; i < 64 * 128; i += NTHR) { const int kk = i >> 7, c = i & 127; At[kk * 129 + c] = w_in_l[(size_t)(64 * kt + kk) * INW + g * 128 + c]; }
    __syncthreads();
    {
        const int e = eh * 64 + (tid & 63), c0 = (tid >> 6) * 16; const int off = ri ? 32 : 0;
        float acc[16];
#pragma unroll
        for (int j = 0; j < 16; ++j) acc[j] = 0.f;
        const float* wf = wf_l + (size_t)g * 128 * 128 + e;
        for (int d = 0; d < 128; ++d) { const float w = wf[d * 128];
#pragma unroll
            for (int j = 0; j < 16; ++j) acc[j] += tab[((c0 + j) * d + off) & 127] * w; }
#pragma unroll
        for (int j = 0; j < 16; ++j) Mt[(c0 + j) * 64 + (tid & 63)] = acc[j] * 0.08838834764831845f;
    }
    __syncthreads();
    {
        const int kk = tid & 63, e0 = (tid >> 6) * 8; float acc[8];
#pragma unroll
        for (int j = 0; j < 8; ++j) acc[j] = 0.f;
        for (int c = 0; c < 128; ++c) { const float a = At[kk * 129 + c]; const f32x4 m0 = *(const LAS f32x4*)(Mt + c * 64 + e0), m1 = *(const LAS f32x4*)(Mt + c * 64 + e0 + 4);
            acc[0] += a * m0.x; acc[1] += a * m0.y; acc[2] += a * m0.z; acc[3] += a * m0.w; acc[4] += a * m1.x; acc[5] += a * m1.y; acc[6] += a * m1.z; acc[7] += a * m1.w; }
#pragma unroll
        for (int j = 0; j < 8; ++j) wt_in_l[(size_t)(ri * 512 + g * 128 + eh * 64 + e0 + j) * DM + 64 * kt + kk] = (bf16)f2bf(acc[j]);
    }
    __syncthreads();
}
__device__ __forceinline__ void make_tables(unsigned char* tabs, int gtid, int gthreads) {
    bf16* A1P = (bf16*)(tabs + T_A1P); bf16* A1S = (bf16*)(tabs + T_A1S); bf16* A2P = (bf16*)(tabs + T_A2P); bf16* A2S = (bf16*)(tabs + T_A2S);
    float2* TWP = (float2*)(tabs + T_TWP); float2* TWS = (float2*)(tabs + T_TWS);
    for (int i = gtid; i < 128 * 128; i += gthreads) {
        const int m = i >> 7, k = i & 127, k1 = m & 63, s1 = k & 63; const float x = (float)((k1 * s1) & 63) * (1.0f / 32.0f);
        const float c = cospif(x) * 0.125f, s = sinpif(x) * 0.125f; const int im = m >> 6, vi = k >> 6;
        A1P[i] = (bf16)f2bf(im == 0 ? (vi == 0 ? c : s) : (vi == 0 ? -s : c)); }
    for (int i = gtid; i < 256 * 256; i += gthreads) {
        const int m = i >> 8, k = i & 255, k1 = m & 127, s1 = k & 127; const float x = (float)((k1 * s1) & 127) * (1.0f / 64.0f);
        const float sc = 0.08838834764831845f; const float c = cospif(x) * sc, s = sinpif(x) * sc; const int im = m >> 7, vi = k >> 7;
        A1S[i] = (bf16)f2bf(im == 0 ? (vi == 0 ? c : s) : (vi == 0 ? -s : c)); }
    for (int i = gtid; i < 64 * 128; i += gthreads) {
        const int k2 = i >> 7, k = i & 127, s2 = k & 63; const float x = (float)((k2 * s2) & 63) * (1.0f / 32.0f);
        A2P[i] = (bf16)f2bf((k >> 6) == 0 ? cospif(x) * 0.125f : sinpif(x) * 0.125f); }
    for (int i = gtid; i < 128 * 256; i += gthreads) {
        const int k2 = i >> 8, k = i & 255, s2 = k & 127; const float x = (float)((k2 * s2) & 127) * (1.0f / 64.0f); const float sc = 0.08838834764831845f;
        A2S[i] = (bf16)f2bf((k >> 7) == 0 ? cospif(x) * sc : sinpif(x) * sc); }
    for (int i = gtid; i < 64 * 64; i += gthreads) {
        const int s2 = i >> 6, k1 = i & 63; const float x = (float)(s2 * k1) * (1.0f / 2048.0f); TWP[i] = make_float2(cospif(x), -sinpif(x)); }
    for (int i = gtid; i < 128 * 128; i += gthreads) {
        const int s2 = i >> 7, k1 = i & 127; const float x = (float)(s2 * k1) * (1.0f / 8192.0f); TWS[i] = make_float2(cospif(x), -sinpif(x)); }
}

template <int N, bool S1>
__device__ __forceinline__ void fft_tasks(LAS unsigned char* lds, const bf16* SRC, bf16* DST, const bf16* Amat, const float2* TW, int u0, int ustride, int uend, int tid) {
    constexpr int K2 = 2 * N, RS = 320, NCH = K2 * 16 / NTHR, TILE = K2 * RS, NIT = N / 64, KS = K2 / 16, SLD = S1 ? NPROJ : DM, LOGN = (N == 64) ? 6 : 7;
    constexpr bool PERSIST = (N == 64);
    const int lane = tid & 63, w = __builtin_amdgcn_readfirstlane(tid >> 6), h = lane >> 5, c32 = lane & 31, i16 = lane & 15;
    const int troff = (8 * h + (i16 >> 2)) * RS + (16 * ((lane >> 4) & 1) + 4 * (i16 & 3)) * 2 + (w & 3) * 64;
    const int nt = w & 3;
    bf16x8 af0[PERSIST ? KS : 1], af1[(PERSIST && S1) ? KS : 1];
    if constexpr (PERSIST) { const bf16* ap = Amat + (size_t)(32 * (w >> 2) + c32) * K2 + 8 * h;
#pragma unroll
        for (int ks = 0; ks < KS; ++ks) { af0[ks] = *(const bf16x8*)(ap + 16 * ks); if constexpr (S1) af1[ks] = *(const bf16x8*)(ap + (size_t)N * K2 + 16 * ks); } }
    u32x4 pre[NCH];
#define FFT_LOAD(uu) do { const int g_ = (uu) & 3, idx_ = ((uu) >> 2) & (N - 1); const size_t rb_ = (N == 64) ? (size_t)((uu) >> (2 + LOGN)) * SP : (size_t)MP; \
        _Pragma("unroll") for (int i_ = 0; i_ < NCH; ++i_) { const int c_ = tid + NTHR * i_, r_ = c_ >> 4, ch_ = c_ & 15, j_ = r_ & (N - 1), im_ = r_ / N; \
            const size_t row_ = S1 ? rb_ + (size_t)j_ * N + idx_ : rb_ + (size_t)idx_ * N + j_; \
            pre[i_] = *(const u32x4*)(SRC + row_ * SLD + im_ * 512 + g_ * 128 + ch_ * 8); } } while (0)
    int u = u0, buf = 0;
    if (PERSIST && u < uend) FFT_LOAD(u);
    for (; u < uend; u += ustride) {
        const int g = u & 3, idx = (u >> 2) & (N - 1); const size_t rb = (N == 64) ? (size_t)(u >> (2 + LOGN)) * SP : (size_t)MP;
        if (!PERSIST) FFT_LOAD(u);
        LAS unsigned char* T = lds + (PERSIST ? buf * TILE : 0);
#pragma unroll
        for (int i = 0; i < NCH; ++i) { const int c = tid + NTHR * i; *(LAS u32x4*)(T + (c >> 4) * RS + (c & 15) * 16) = pre[i]; }
        float2 tw[NIT];
        if constexpr (S1) {
#pragma unroll
            for (int it = 0; it < NIT; ++it) tw[it] = TW[idx * N + 32 * ((w >> 2) + 2 * it) + c32]; }
        __syncthreads();
        if (PERSIST && u + ustride < uend) FFT_LOAD(u + ustride);
#pragma unroll
        for (int it = 0; it < NIT; ++it) {
            const int mi = (w >> 2) + 2 * it, no = 32 * mi + c32;
            f32x16 are, aim;
#pragma unroll
            for (int r = 0; r < 16; ++r) { are[r] = 0.f; aim[r] = 0.f; }
            const bf16* ap = Amat + (size_t)no * K2 + 8 * h;
            const LAS unsigned char* tb = T + troff;
#pragma unroll 8
            for (int ks = 0; ks < KS; ++ks) {
                const bf16x8 xf = cat8(vtr(tb + ks * 16 * RS), vtr(tb + ks * 16 * RS + 4 * RS));
                bf16x8 b0, b1;
                if constexpr (PERSIST) { b0 = af0[ks]; if constexpr (S1) b1 = af1[ks]; }
                else { b0 = *(const bf16x8*)(ap + 16 * ks); if constexpr (S1) b1 = *(const bf16x8*)(ap + (size_t)N * K2 + 16 * ks); }
                are = __builtin_amdgcn_mfma_f32_32x32x16_bf16(xf, b0, are, 0, 0, 0);
                if constexpr (S1) aim = __builtin_amdgcn_mfma_f32_32x32x16_bf16(xf, b1, aim, 0, 0, 0);
            }
            bf16* o = S1 ? DST + (rb + (size_t)no * N + idx) * DM + g * 128 + 32 * nt + 4 * h
                         : DST + (rb + (size_t)idx + (size_t)N * no) * DM + g * 128 + 32 * nt + 4 * h;
#pragma unroll
            for (int j = 0; j < 4; ++j) {
                if constexpr (S1) { float zr[4], zi[4];
#pragma unroll
                    for (int q = 0; q < 4; ++q) { zr[q] = are[4 * j + q] * tw[it].x - aim[4 * j + q] * tw[it].y; zi[q] = are[4 * j + q] * tw[it].y + aim[4 * j + q] * tw[it].x; }
                    u32x2 a, b; a.x = cvtpk(zr[0], zr[1]); a.y = cvtpk(zr[2], zr[3]); b.x = cvtpk(zi[0], zi[1]); b.y = cvtpk(zi[2], zi[3]);
                    *(u32x2*)(o + 8 * j) = a; *(u32x2*)(o + 512 + 8 * j) = b;
                } else { u32x2 a; a.x = cvtpk(are[4 * j], are[4 * j + 1]); a.y = cvtpk(are[4 * j + 2], are[4 * j + 3]); *(u32x2*)(o + 8 * j) = a; }
            }
        }
        if constexpr (PERSIST) buf ^= 1; else __syncthreads();
    }
#undef FFT_LOAD
    __syncthreads();
}

__device__ __forceinline__ void attn_task(LAS unsigned char* lds, const bf16* PROJ, bf16* HEADS, const float* sink, size_t row_base, int S, int n, int kv, int tid) {
    constexpr int KRS = 144, VT = 384 * 64;
    LAS unsigned char* Kl = lds; LAS unsigned char* Vl = lds + 384 * KRS;
    const int nb = S / 128;
    {   u32x4 kk[6], vv[6];
#pragma unroll
        for (int i = 0; i < 6; ++i) { const int c = tid + NTHR * i, si = c >> 3, ch = c & 7, kp = n * 128 - 128 + si;
            kk[i] = (u32x4){0u, 0u, 0u, 0u}; vv[i] = (u32x4){0u, 0u, 0u, 0u};
            if (kp >= 0 && kp < S) { const bf16* src = PROJ + (row_base + (size_t)kp) * NPROJ + 1536 + kv * 64 + ch * 8; kk[i] = *(const u32x4*)src; vv[i] = *(const u32x4*)(src + 128); } }
#pragma unroll
        for (int i = 0; i < 6; ++i) { const int c = tid + NTHR * i, si = c >> 3, ch = c & 7;
            *(LAS u32x4*)(Kl + si * KRS + ch * 16) = kk[i];
            *(LAS u32x4*)(Vl + (ch >> 2) * VT + si * 64 + (ch & 3) * 16) = vv[i]; }
    }
    __syncthreads();
    const int lane = tid & 63, w = __builtin_amdgcn_readfirstlane(tid >> 6), h = lane >> 5, c32 = lane & 31, i16 = lane & 15;
    const int lo_valid = (n == 0) ? 128 : 0, hi_valid = (n == nb - 1) ? 256 : 384;
    const int vtoff = (4 * h + (i16 >> 2)) * 64 + (16 * ((lane >> 4) & 1) + 4 * (i16 & 3)) * 2;
    for (int qt = w; qt < 16; qt += NWAVES) {
        const int hh = qt >> 2, qo = 32 * (qt & 3), head = kv * 4 + hh, qi = qo + c32;
        const float slope2 = __builtin_amdgcn_exp2f(-(float)(head + 1)) * LOG2E;
        const size_t qrow = row_base + (size_t)n * 128 + qi;
        bf16x8 qf[4];
#pragma unroll
        for (int ds = 0; ds < 4; ++ds) qf[ds] = *(const bf16x8*)(PROJ + qrow * NPROJ + 1024 + head * 64 + 16 * ds + 8 * h);
        float m = sink[head] * LOG2E, l = (h == 0) ? 1.f : 0.f;
        f32x16 o0, o1;
#pragma unroll
        for (int r = 0; r < 16; ++r) { o0[r] = 0.f; o1[r] = 0.f; }
        const float relb = (float)(4 * h - 128 - c32);
        for (int kt = 0; kt < 9; ++kt) {
            const int si0 = qo + 32 * kt;
            if (si0 < lo_valid || si0 >= hi_valid) continue;
            f32x16 s;
#pragma unroll
            for (int r = 0; r < 16; ++r) s[r] = 0.f;
#pragma unroll
            for (int ds = 0; ds < 4; ++ds) { const bf16x8 kf = *(const LAS bf16x8*)(Kl + (si0 + c32) * KRS + (16 * ds + 8 * h) * 2); s = __builtin_amdgcn_mfma_f32_32x32x16_bf16(kf, qf[ds], s, 0, 0, 0); }
            const float rel0 = relb + (float)(32 * kt);
            float mx = m;
            if (kt == 0 || kt == 8) {
#pragma unroll
                for (int r = 0; r < 16; ++r) { const float d = fabsf(rel0 + (float)((r & 3) + 8 * (r >> 2)));
                    float t = __builtin_fmaf(-slope2, d, s[r] * (0.125f * LOG2E)); t = (d <= 128.f) ? t : -1e30f; s[r] = t; mx = fmaxf(mx, t); }
            } else {
#pragma unroll
                for (int r = 0; r < 16; ++r) { const float d = fabsf(rel0 + (float)((r & 3) + 8 * (r >> 2)));
                    const float t = __builtin_fmaf(-slope2, d, s[r] * (0.125f * LOG2E)); s[r] = t; mx = fmaxf(mx, t); }
            }
            mx = fmaxf(mx, __shfl_xor(mx, 32));
            if (__any(mx > m)) {
                const float alpha = __builtin_amdgcn_exp2f(m - mx); m = mx; l *= alpha;
#pragma unroll
                for (int r = 0; r < 16; ++r) { o0[r] *= alpha; o1[r] *= alpha; }
            }
            float ps = 0.f;
#pragma unroll
            for (int r = 0; r < 16; ++r) { const float p = __builtin_amdgcn_exp2f(s[r] - m); s[r] = p; ps += p; }
            l += ps;
            u32x4 p0, p1;
            p0.x = cvtpk(s[0], s[1]); p0.y = cvtpk(s[2], s[3]); p0.z = cvtpk(s[4], s[5]); p0.w = cvtpk(s[6], s[7]);
            p1.x = cvtpk(s[8], s[9]); p1.y = cvtpk(s[10], s[11]); p1.z = cvtpk(s[12], s[13]); p1.w = cvtpk(s[14], s[15]);
            const bf16x8 pf0 = __builtin_bit_cast(bf16x8, p0), pf1 = __builtin_bit_cast(bf16x8, p1);
            const LAS unsigned char* vb = Vl + si0 * 64 + vtoff;
            {   const bf16x8 v00 = cat8(vtr(vb), vtr(vb + 8 * 64)), v01 = cat8(vtr(vb + 16 * 64), vtr(vb + 24 * 64));
                o0 = __builtin_amdgcn_mfma_f32_32x32x16_bf16(v00, pf0, o0, 0, 0, 0); o0 = __builtin_amdgcn_mfma_f32_32x32x16_bf16(v01, pf1, o0, 0, 0, 0); }
            {   const bf16x8 v10 = cat8(vtr(vb + VT), vtr(vb + VT + 8 * 64)), v11 = cat8(vtr(vb + VT + 16 * 64), vtr(vb + VT + 24 * 64));
                o1 = __builtin_amdgcn_mfma_f32_32x32x16_bf16(v10, pf0, o1, 0, 0, 0); o1 = __builtin_amdgcn_mfma_f32_32x32x16_bf16(v11, pf1, o1, 0, 0, 0); }
        }
        l += __shfl_xor(l, 32);
        const float inv = 1.0f / l;
        bf16* orow = HEADS + qrow * DM + 512 + head * 64 + 4 * h;
#pragma unroll
        for (int r4 = 0; r4 < 4; ++r4) {
            u32x2 a, b; a.x = cvtpk(o0[4 * r4] * inv, o0[4 * r4 + 1] * inv); a.y = cvtpk(o0[4 * r4 + 2] * inv, o0[4 * r4 + 3] * inv);
            b.x = cvtpk(o1[4 * r4] * inv, o1[4 * r4 + 1] * inv); b.y = cvtpk(o1[4 * r4 + 2] * inv, o1[4 * r4 + 3] * inv);
            *(u32x2*)(orow + 8 * r4) = a; *(u32x2*)(orow + 32 + 8 * r4) = b; }
    }
    __syncthreads();
}

__device__ __forceinline__ void ln_pass(const bf16* Z, const float* gam, const float* bet, bf16* Xo, float* Fo, int gw, int ngw, int lane) {
    f32x4 g0 = ((const f32x4*)gam)[2 * lane], g1 = ((const f32x4*)gam)[2 * lane + 1], g2 = ((const f32x4*)gam)[128 + 2 * lane], g3 = ((const f32x4*)gam)[128 + 2 * lane + 1];
    f32x4 b0 = ((const f32x4*)bet)[2 * lane], b1 = ((const f32x4*)bet)[2 * lane + 1], b2 = ((const f32x4*)bet)[128 + 2 * lane], b3 = ((const f32x4*)bet)[128 + 2 * lane + 1];
    for (int m = gw; m < MTOK; m += ngw) {
        const u32x4 a = *(const u32x4*)(Z + (size_t)m * DM + 8 * lane), c = *(const u32x4*)(Z + (size_t)m * DM + 512 + 8 * lane);
        f32x4 v0 = {bflo(a.x), bfhi(a.x), bflo(a.y), bfhi(a.y)}, v1 = {bflo(a.z), bfhi(a.z), bflo(a.w), bfhi(a.w)};
        f32x4 v2 = {bflo(c.x), bfhi(c.x), bflo(c.y), bfhi(c.y)}, v3 = {bflo(c.z), bfhi(c.z), bflo(c.w), bfhi(c.w)};
        f32x4 t = (v0 + v1) + (v2 + v3);
        const float mean = wave_sum((t.x + t.y) + (t.z + t.w)) * (1.f / DM);
        v0 = v0 - mean; v1 = v1 - mean; v2 = v2 - mean; v3 = v3 - mean;
        t = (v0 * v0 + v1 * v1) + (v2 * v2 + v3 * v3);
        const float rstd = 1.f / sqrtf(wave_sum((t.x + t.y) + (t.z + t.w)) * (1.f / DM) + LN_EPS);
        v0 = v0 * rstd * g0 + b0; v1 = v1 * rstd * g1 + b1; v2 = v2 * rstd * g2 + b2; v3 = v3 * rstd * g3 + b3;
        if (Fo) { f32x4* o = (f32x4*)(Fo + (size_t)m * DM + 8 * lane); o[0] = v0; o[1] = v1; o[128] = v2; o[129] = v3; }
        else { u32x4 w0, w1; w0.x = pk2(v0.x, v0.y); w0.y = pk2(v0.z, v0.w); w0.z = pk2(v1.x, v1.y); w0.w = pk2(v1.z, v1.w);
            w1.x = pk2(v2.x, v2.y); w1.y = pk2(v2.z, v2.w); w1.z = pk2(v3.x, v3.y); w1.w = pk2(v3.z, v3.w);
            *(u32x4*)(Xo + (size_t)m * DM + 8 * lane) = w0; *(u32x4*)(Xo + (size_t)m * DM + 512 + 8 * lane) = w1; }
    }
}

#define XB_TMO      128
#define XB_XCNT(j)  (256  + 64 * (j))
#define XB_XSUB(j)  (1280 + 64 * (j))
#define XB_XGEN(j)  (2304 + 64 * (j))
#define XB_TOP      3328
#define XB_TOPGEN   3392
#define XCD_BAR_WORDS 3456
#define XB_SPIN_CAP (1u << 18)

__device__ __forceinline__ unsigned xb_ld(unsigned* p)              { return __hip_atomic_load(p, __ATOMIC_RELAXED, __HIP_MEMORY_SCOPE_AGENT); }
__device__ __forceinline__ unsigned xb_add(unsigned* p, unsigned v) { return __hip_atomic_fetch_add(p, v, __ATOMIC_RELAXED, __HIP_MEMORY_SCOPE_AGENT); }
__device__ __forceinline__ unsigned xb_xcc_id() { return (unsigned)__builtin_amdgcn_s_getreg((3 << 11) | 20) & 0xFu; }
#define XB_SPIN(cond, bar) do { unsigned _sp = 0; while (cond) { __builtin_amdgcn_s_sleep(1); \
    if ((++_sp & 255u) == 0u) { if (xb_ld(&(bar)[XB_TMO])) break; if (_sp > XB_SPIN_CAP) { atomicAdd(&(bar)[XB_TMO], 1u); break; } } } } while (0)

struct XcdBarrier {
    unsigned* bar; unsigned x;
    volatile LAS unsigned* st;
};

__device__ __forceinline__ XcdBarrier xcd_barrier_post(unsigned* bar, volatile LAS unsigned* st) {
    XcdBarrier b; b.bar = bar; b.x = xb_xcc_id(); b.st = st;
    if (threadIdx.x == 0) (void)xb_add(&bar[XB_XCNT(b.x)], 1u);
    return b;
}
__device__ __forceinline__ void xcd_barrier_complete(unsigned* bar, unsigned x, unsigned& nloc, unsigned& nx) {
    const unsigned G = gridDim.x * gridDim.y * gridDim.z;
    unsigned sum, cnt, mine, sp = 0u;
    for (;;) {
        sum = 0u; cnt = 0u; mine = 0u;
#pragma unroll
        for (unsigned j = 0; j < 16; ++j) { const unsigned c = xb_ld(&bar[XB_XCNT(j)]); sum += c; cnt += (c > 0u) ? 1u : 0u; mine = (j == x) ? c : mine; }
        if (sum == G) break;
        __builtin_amdgcn_s_sleep(1);
        if ((++sp & 255u) == 0u) { if (xb_ld(&bar[XB_TMO])) break; if (sp > XB_SPIN_CAP) { atomicAdd(&bar[XB_TMO], 1u); break; } }
    }
    nloc = mine > 0u ? mine : 1u; nx = cnt > 0u ? cnt : 1u;
}

__device__ __forceinline__ void xcd_barrier(const XcdBarrier& b) {
    asm volatile("s_waitcnt vmcnt(0)" ::: "memory");
    __syncthreads();
    if (threadIdx.x == 0) {
        unsigned* bar = b.bar;
        __builtin_amdgcn_s_waitcnt(0);
        unsigned nloc = b.st[0], nx = b.st[1];
        if (nloc == 0u) { xcd_barrier_complete(bar, b.x, nloc, nx); b.st[0] = nloc; b.st[1] = nx; }
        const unsigned old = xb_add(&bar[XB_XSUB(b.x)], 1u);
        const unsigned gen = old / nloc;
        if (old + 1u == (gen + 1u) * nloc) {
            __builtin_amdgcn_fence(__ATOMIC_RELEASE, "agent");
            asm volatile("s_waitcnt vmcnt(0)" ::: "memory");
            const unsigned og = xb_add(&bar[XB_TOP], 1u);
            const unsigned tg = og / nx;
            if (og + 1u == (tg + 1u) * nx) xb_add(&bar[XB_TOPGEN], 1u);
            else XB_SPIN(xb_ld(&bar[XB_TOPGEN]) == tg, bar);
            __builtin_amdgcn_fence(__ATOMIC_ACQUIRE, "agent");
            xb_add(&bar[XB_XGEN(b.x)], 1u);
            asm volatile("s_waitcnt vmcnt(0)" ::: "memory");
        } else {
            XB_SPIN(xb_ld(&bar[XB_XGEN(b.x)]) == gen, bar);
            __builtin_amdgcn_fence(__ATOMIC_ACQUIRE, "agent");
            asm volatile("s_waitcnt vmcnt(0)" ::: "memory");
        }
    }
    __syncthreads();
}

struct Args { const float* in[14]; float* out; unsigned char* ws; int ph_lo, ph_hi; };
constexpr int NPHASE = 17;
#ifndef DUP_MIX
#define DUP_MIX 1
#endif
#ifndef DUP_ATT
#define DUP_ATT 0
#endif
#ifndef DUP_LN
#define DUP_LN 1
#endif
#ifndef DUP_P0
#define DUP_P0 1
#endif
typedef const __attribute__((address_space(4))) Args* ArgsP;
__device__ __forceinline__ ArgsP get_args() { ArgsP p = (ArgsP)__builtin_amdgcn_kernarg_segment_ptr(); asm volatile("" : "+s"(p)); return p; }
#define WSP(ap, off) ((ap)->ws + (off))
#define XBUF(ap) ((bf16*)WSP(ap, WS_X))
#define ZBUF(ap) ((bf16*)WSP(ap, WS_Z))
#define HBUF(ap) ((bf16*)WSP(ap, WS_H))
#define PROJBUF(ap) ((bf16*)WSP(ap, WS_PROJ))
#define ZPBUF(ap) ((bf16*)(ap)->out)
#define HEADSBUF(ap) ((bf16*)(ap)->out + (size_t)MTOK * DM)
#define TABS(ap) WSP(ap, WS_TAB)
#define WL(ap, L, off) ((const bf16*)WSP(ap, WS_W + (size_t)(L) * W_LAYER + (off)))
__global__ void __launch_bounds__(NTHR, 2) hymba_fwd(Args args_unused) {
    extern __shared__ __attribute__((aligned(16))) unsigned char lds_raw[];
    LAS unsigned char* lds = (LAS unsigned char*)lds_raw;
    cg::grid_group grid = cg::this_grid();
    const int G = gridDim.x, bx = blockIdx.x;
    {
        volatile LAS unsigned* MISC0 = (volatile LAS unsigned*)(lds + 131072 + 320);
        if (threadIdx.x < 32) MISC0[threadIdx.x] = 0u;
        if (bx == 0) { unsigned* bw = (unsigned*)get_args()->ws + 4096; for (int i = threadIdx.x; i < XCD_BAR_WORDS; i += NTHR) bw[i] = 0u; }
        __syncthreads();
    }
#define XBAR() do { XcdBarrier b_; b_.bar = (unsigned*)get_args()->ws + 4096; b_.x = xb_xcc_id(); b_.st = (volatile LAS unsigned*)(lds + 131072 + 320) + 8; xcd_barrier(b_); } while (0)
#define FRESH() int tid = threadIdx.x; asm volatile("" : "+v"(tid)); const int lane = tid & 63, wave = __builtin_amdgcn_readfirstlane(tid >> 6); (void)lane; (void)wave;
#define IN(k) (get_args()->ph_lo <= (k) && (k) < get_args()->ph_hi)
#ifndef DUP_SYNC
#define DUP_SYNC 1
#endif
#define SEAM(k) do { if (IN(k) && IN((k) + 1)) { for (int rs = 0; rs < DUP_SYNC; ++rs) XBAR(); } } while (0)

    for (int rep0 = 0; rep0 < DUP_P0; ++rep0) if (IN(0)) {
        if (rep0) __syncthreads();
        FRESH(); ArgsP ap = get_args();
        for (int t = bx; t < 512; t += G) { const int L = t >> 8;
            fold_task(lds, ap->in[4] + (size_t)L * DM * INW, ap->in[5] + (size_t)L * 4 * 128 * 128, (bf16*)WL(ap, L, W_IN), t & 255, tid); }
        LAS float* scr = (LAS float*)(lds + wave * 16384);
        const int gw = bx * NWAVES + wave, ngw = G * NWAVES;
        constexpr int I_QKV = 16 * 24, I_O = 16 * 32, I_1 = 16 * 128, I_2 = 64 * 32, I_L = I_QKV + I_O + I_1 + I_2;
        for (int it = gw; it < 2 * I_L; it += ngw) {
            const int L = it / I_L; int r = it % I_L;
            if (r < I_QKV) { p0_transpose_item(ap->in[4] + (size_t)L * DM * INW, INW, 512, 768, DM, (bf16*)WL(ap, L, W_IN), 1024, scr, r, lane); continue; } r -= I_QKV;
            if (r < I_O) { p0_transpose_item(ap->in[7] + (size_t)L * DM * DM, DM, 0, DM, DM, (bf16*)WL(ap, L, W_OUT), 0, scr, r, lane); continue; } r -= I_O;
            if (r < I_1) { p0_transpose_item(ap->in[10] + (size_t)L * DM * DFF, DFF, 0, DFF, DM, (bf16*)WL(ap, L, W_FF1), 0, scr, r, lane); continue; } r -= I_1;
            p0_transpose_item(ap->in[11] + (size_t)L * DFF * DM, DM, 0, DM, DFF, (bf16*)WL(ap, L, W_FF2), 0, scr, r, lane);
        }
        { const float* x_prompt = ap->in[0]; const float* x_sample = ap->in[1]; const float* eg = ap->in[2]; const float* eb = ap->in[3]; bf16* X = XBUF(ap);
          for (int m = gw; m < MTOK; m += ngw) { const float* xr = m < MP ? x_prompt + (size_t)m * DM : x_sample + (size_t)(m - MP) * DM; ln_emb_row(xr, eg, eb, X + (size_t)m * DM, lane); } }
        make_tables(TABS(ap), bx * NTHR + tid, G * NTHR);
    }
    if (IN(0) && IN(1)) { grid.sync(); (void)xcd_barrier_post((unsigned*)get_args()->ws + 4096, (volatile LAS unsigned*)(lds + 131072 + 320) + 8); }
    for (int L = 0; L < 2; ++L) {
        const int pb = 1 + 8 * L;
        if (IN(pb + 0)) {
            ArgsP ap = get_args();
            pg8::Gemm g{XBUF(ap), WL(ap, L, W_IN), MTOK, NPROJ, DM}; pg8::StaticOrder S; S.init(MTOK, NPROJ, G, bx);
            pg8::EpiBf16<0> E{PROJBUF(ap), NPROJ, nullptr, 0, 0, 1.f};
            pg8::gemm_phase<pg8::EpiBf16<0>, pg8::StaticOrder, true, true>(lds, g, S, E);
        }
        SEAM(pb + 0);
        for (int rep = 0; rep < DUP_MIX + DUP_ATT; ++rep) if (IN(pb + 1)) {
            FRESH(); ArgsP ap = get_args();
            const float* sink = ap->in[6] + L * 8; const bf16* PROJ = PROJBUF(ap); bf16* HEADS = HEADSBUF(ap); bf16* ZP = ZPBUF(ap); const unsigned char* tabs = TABS(ap);
            for (int t = bx; t < (rep >= DUP_MIX ? 1280 : 1280); t += G) {
                if (t < 1024) { const int kv = t & 1, n = (t >> 1) & 31, b = t >> 6; attn_task(lds, PROJ, HEADS, sink, (size_t)b * SP, SP, n, kv, tid); }
                else { const int u = t - 1024, kv = u & 1, n = u >> 1; attn_task(lds, PROJ, HEADS, sink, (size_t)MP, SS, n, kv, tid); }
            }
            if (rep < DUP_MIX) {
                fft_tasks<64, true>(lds, PROJ, ZP, (const bf16*)(tabs + T_A1P), (const float2*)(tabs + T_TWP), bx, G, 4096, tid);
                fft_tasks<128, true>(lds, PROJ, ZP, (const bf16*)(tabs + T_A1S), (const float2*)(tabs + T_TWS), bx, G, 512, tid);
            }
        }
        SEAM(pb + 1);
        for (int rep = 0; rep < DUP_MIX; ++rep) if (IN(pb + 2)) {
            FRESH(); ArgsP ap = get_args();
            const bf16* ZP = ZPBUF(ap); bf16* HEADS = HEADSBUF(ap); const unsigned char* tabs = TABS(ap);
            fft_tasks<64, false>(lds, ZP, HEADS, (const bf16*)(tabs + T_A2P), nullptr, bx, G, 4096, tid);
            fft_tasks<128, false>(lds, ZP, HEADS, (const bf16*)(tabs + T_A2S), nullptr, bx, G, 512, tid);
        }
        SEAM(pb + 2);
        if (IN(pb + 3)) {
            ArgsP ap = get_args();
            pg8::Gemm g{HEADSBUF(ap), WL(ap, L, W_OUT), MTOK, DM, DM}; pg8::StaticOrder S; S.init(MTOK, DM, G, bx);
            pg8::EpiRes E{XBUF(ap), ZBUF(ap), DM, ALPHA};
            pg8::gemm_phase<pg8::EpiRes, pg8::StaticOrder, true, true>(lds, g, S, E);
        }
        SEAM(pb + 3);
        for (int rep = 0; rep < DUP_LN; ++rep) if (IN(pb + 4)) { FRESH(); ArgsP ap = get_args(); ln_pass(ZBUF(ap), ap->in[8] + L * DM, ap->in[9] + L * DM, XBUF(ap), nullptr, bx * NWAVES + wave, G * NWAVES, lane); }
        SEAM(pb + 4);
        if (IN(pb + 5)) {
            ArgsP ap = get_args();
            pg8::Gemm g{XBUF(ap), WL(ap, L, W_FF1), MTOK, DFF, DM}; pg8::StaticOrder S; S.init(MTOK, DFF, G, bx);
            pg8::EpiBf16<2> E{HBUF(ap), DFF, nullptr, 0, 0, 1.f};
            pg8::gemm_phase<pg8::EpiBf16<2>, pg8::StaticOrder, true, true>(lds, g, S, E);
        }
        SEAM(pb + 5);
        if (IN(pb + 6)) {
            ArgsP ap = get_args();
            pg8::Gemm g{HBUF(ap), WL(ap, L, W_FF2), MTOK, DM, DFF}; pg8::StaticOrder S; S.init(MTOK, DM, G, bx);
            pg8::EpiRes E{XBUF(ap), ZBUF(ap), DM, ALPHA};
            pg8::gemm_phase<pg8::EpiRes, pg8::StaticOrder, true, true>(lds, g, S, E);
        }
        SEAM(pb + 6);
        for (int rep = 0; rep < DUP_LN; ++rep) if (IN(pb + 7)) { FRESH(); ArgsP ap = get_args(); ln_pass(ZBUF(ap), ap->in[12] + L * DM, ap->in[13] + L * DM, XBUF(ap), L == 1 ? ap->out : nullptr, bx * NWAVES + wave, G * NWAVES, lane); }
        if (L == 0) SEAM(pb + 7);
    }
#undef IN
#undef SEAM
}

#ifndef MK_ONE_LAUNCH
#define MK_ONE_LAUNCH 1
#endif
extern "C" void kernel_launch(void* const* d_in, const int* in_sizes, int n_in, void* d_out, int out_size, void* d_ws, size_t ws_size, hipStream_t stream) {
    static int grid = 0;
    if (grid == 0) {
        if (n_in != 14 || out_size != MTOK * DM || ws_size < WS_END) { fprintf(stderr, "kernel_launch: unexpected shapes (n_in %d, out %d, ws %zu); nothing launched\n", n_in, out_size, ws_size); grid = -1; return; }
        int dev = 0, cus = 0, per_cu = 0;
        hipGetDevice(&dev); hipDeviceGetAttribute(&cus, hipDeviceAttributeMultiprocessorCount, dev);
        if (hipFuncSetAttribute((const void*)hymba_fwd, hipFuncAttributeMaxDynamicSharedMemorySize, LDS_BYTES) != hipSuccess) { fprintf(stderr, "kernel_launch: hipFuncSetAttribute failed\n"); grid = -1; return; }
        if (hipOccupancyMaxActiveBlocksPerMultiprocessor(&per_cu, (const void*)hymba_fwd, NTHR, LDS_BYTES) != hipSuccess || per_cu < 1) { fprintf(stderr, "kernel_launch: occupancy query says %d\n", per_cu); per_cu = 1; }
        (void)hipGetLastError();
        grid = cus * per_cu;
        fprintf(stderr, "kernel_launch: grid %d (%d CUs x %d)\n", grid, cus, per_cu);
    }
    if (grid < 0) return;
    Args a{};
    for (int i = 0; i < 14; ++i) a.in[i] = (const float*)d_in[i];
    a.out = (float*)d_out; a.ws = (unsigned char*)d_ws;
#if MK_ONE_LAUNCH
    a.ph_lo = 0; a.ph_hi = NPHASE;
    void* kargs[] = {&a};
    hipError_t e = hipLaunchCooperativeKernel((const void*)hymba_fwd, dim3(grid), dim3(NTHR), kargs, LDS_BYTES, stream);
    if (e != hipSuccess) fprintf(stderr, "kernel_launch: cooperative launch failed: %s (grid %d)\n", hipGetErrorString(e), grid);
#else
    for (int p = 0; p < NPHASE; ++p) { a.ph_lo = p; a.ph_hi = p + 1; hipLaunchKernelGGL(hymba_fwd, dim3(grid), dim3(NTHR), LDS_BYTES, stream, a); }
#endif
}
```
